# Optimizing an MI355X kernel written in HIP

```python
import jax, jax.numpy as jnp
from jax import lax
import numpy as np

D_MODEL = 2048
BATCH = 1
SEQ = 8192
DEPTH = 1

FOX_HEADS = 8
FOX_HEAD_DIM = 128
FOX_WIDTH = FOX_HEADS * FOX_HEAD_DIM
SWA_Q_HEADS = 16
SWA_KV_HEADS = 4
SWA_HEAD_DIM = 64
SWA_GROUP = SWA_Q_HEADS // SWA_KV_HEADS
SWA_WIDTH = SWA_Q_HEADS * SWA_HEAD_DIM
SWA_KV_WIDTH = SWA_KV_HEADS * SWA_HEAD_DIM
WINDOW = 128
Q_BLOCK = 128
LN_EPS = 1e-5
NEG_INF = -1e30
DEEPNORM_ALPHA = (2.0 * DEPTH) ** 0.25
DEEPNORM_BETA = (8.0 * DEPTH) ** -0.25

_SPLIT_SIZES = (FOX_WIDTH, FOX_WIDTH, FOX_WIDTH, FOX_HEADS,
                SWA_WIDTH, SWA_KV_WIDTH, SWA_KV_WIDTH,
                FOX_WIDTH, SWA_WIDTH,
                D_MODEL, D_MODEL)
IN_WIDTH = sum(_SPLIT_SIZES)
SPLIT_IDX = tuple(int(v) for v in np.cumsum(_SPLIT_SIZES)[:-1])

kernel_name = "hybrid_fox_swa_gated_deepnorm_adaln"


def _layer_norm(x):
    xf = x.astype(jnp.float32)
    mu = jnp.mean(xf, axis=-1, keepdims=True)
    var = jnp.mean(jnp.square(xf - mu), axis=-1, keepdims=True)
    return ((xf - mu) * lax.rsqrt(var + LN_EPS)).astype(x.dtype)


def _forgetting_attention(q, k, v, fgate_logit, b_f):
    B, S, H, Dh = q.shape
    log_f = jax.nn.log_sigmoid(fgate_logit.astype(jnp.float32) + b_f.astype(jnp.float32))
    cum = jnp.cumsum(log_f, axis=1)
    cum_k = cum.transpose(0, 2, 1)[:, :, None, :]
    nb = S // Q_BLOCK
    qb = q.reshape(B, nb, Q_BLOCK, H, Dh).transpose(1, 0, 2, 3, 4)
    cqb = cum.reshape(B, nb, Q_BLOCK, H).transpose(1, 0, 2, 3)
    qpos = jnp.arange(S, dtype=jnp.int32).reshape(nb, Q_BLOCK)
    kpos = jnp.arange(S, dtype=jnp.int32)
    scale = Dh ** -0.5

    def block(args):
        qi, ci, pi = args
        s = jnp.einsum('bqhd,bkhd->bhqk', qi, k).astype(jnp.float32) * scale
        s = s + ci.transpose(0, 2, 1)[..., None] - cum_k
        mask = kpos[None, :] <= pi[:, None]
        s = jnp.where(mask[None, None], s, NEG_INF)
        p = jax.nn.softmax(s, axis=-1).astype(v.dtype)
        return jnp.einsum('bhqk,bkhd->bqhd', p, v)

    out = lax.map(block, (qb, cqb, qpos))
    return out.transpose(1, 0, 2, 3, 4).reshape(B, S, H * Dh)


def _sliding_window_attention(q, k, v, sinks):
    B, S, HQ, d = q.shape
    nb = S // WINDOW
    qb = q.reshape(B, nb, WINDOW, SWA_KV_HEADS, SWA_GROUP, d)
    kb = k.reshape(B, nb, WINDOW, SWA_KV_HEADS, d)
    vb = v.reshape(B, nb, WINDOW, SWA_KV_HEADS, d)
    pad = ((0, 0), (1, 0), (0, 0), (0, 0), (0, 0))
    kk = jnp.concatenate([jnp.pad(kb, pad)[:, :-1], kb], axis=2)
    vv = jnp.concatenate([jnp.pad(vb, pad)[:, :-1], vb], axis=2)
    s = jnp.einsum('bnqhgd,bnkhd->bnhgqk', qb, kk).astype(jnp.float32) * (d ** -0.5)
    i = jnp.arange(WINDOW, dtype=jnp.int32)[:, None]
    j = jnp.arange(2 * WINDOW, dtype=jnp.int32)[None, :]
    dist = (i - j + WINDOW)
    n = jnp.arange(nb, dtype=jnp.int32)[:, None, None]
    kpos_abs = n * WINDOW - WINDOW + j[None]
    valid = (dist[None] >= 0) & (dist[None] < WINDOW) & (kpos_abs >= 0)
    slopes = 2.0 ** (-8.0 * (jnp.arange(HQ, dtype=jnp.float32) + 1.0) / HQ)
    slopes = slopes.reshape(SWA_KV_HEADS, SWA_GROUP)
    s = s - slopes[:, :, None, None] * dist.astype(jnp.float32)
    s = jnp.where(valid[None, :, None, None], s, NEG_INF)
    sink = jnp.broadcast_to(sinks.astype(jnp.float32).reshape(SWA_KV_HEADS, SWA_GROUP)[:, :, None, None],
                            s.shape[:-1] + (1,))
    p = jax.nn.softmax(jnp.concatenate([s, sink], axis=-1), axis=-1)[..., :-1].astype(v.dtype)
    out = jnp.einsum('bnhgqk,bnkhd->bnqhgd', p, vv)
    return out.reshape(B, S, HQ * d)


def setup_inputs(seed: int = 0) -> dict:
    key = jax.random.key(seed)
    ks = jax.random.split(key, 13)
    f32 = jnp.float32
    nrm = lambda k, shape, s: jax.random.normal(k, shape, f32) * s
    x = nrm(ks[0], (BATCH, SEQ, D_MODEL), 1.0)
    c = nrm(ks[1], (BATCH, D_MODEL), 1.0)
    w_ada = nrm(ks[2], (DEPTH, D_MODEL, 3 * D_MODEL), 0.5 * D_MODEL ** -0.5)
    b_ada = nrm(ks[3], (DEPTH, 3 * D_MODEL), 0.02)
    w_in = nrm(ks[4], (DEPTH, D_MODEL, IN_WIDTH), D_MODEL ** -0.5)
    b_f = jnp.linspace(2.0, 7.0, FOX_HEADS, dtype=f32)[None, :] + nrm(ks[5], (DEPTH, FOX_HEADS), 0.1)
    attn_sinks = nrm(ks[6], (DEPTH, SWA_Q_HEADS), 1.0)
    w_br_fox = nrm(ks[7], (DEPTH, FOX_WIDTH, D_MODEL), DEEPNORM_BETA * FOX_WIDTH ** -0.5)
    w_br_swa = nrm(ks[8], (DEPTH, SWA_WIDTH, D_MODEL), DEEPNORM_BETA * SWA_WIDTH ** -0.5)
    w_out = nrm(ks[9], (DEPTH, D_MODEL, D_MODEL), DEEPNORM_BETA * D_MODEL ** -0.5)
    ln_g = 1.0 + nrm(ks[10], (DEPTH, D_MODEL), 0.02)
    ln_b = nrm(ks[11], (DEPTH, D_MODEL), 0.02)
    return {"x": x, "c": c, "w_ada": w_ada, "b_ada": b_ada, "w_in": w_in, "b_f": b_f,
            "attn_sinks": attn_sinks, "w_br_fox": w_br_fox, "w_br_swa": w_br_swa,
            "w_out": w_out, "ln_g": ln_g, "ln_b": ln_b}


def reference(x, c, w_ada, b_ada, w_in, b_f, attn_sinks, w_br_fox, w_br_swa, w_out, ln_g, ln_b):
    B, S, D = x.shape
    for l in range(DEPTH):
        ada = c @ w_ada[l] + b_ada[l]
        shift, scale, gate = jnp.split(ada, 3, axis=-1)
        h = _layer_norm(x) * (1.0 + scale[:, None, :]) + shift[:, None, :]
        proj = h @ w_in[l]
        (fq, fk, fv, flog, sq, sk, sv, g_fox, g_swa, m_fox, m_swa) = jnp.split(proj, SPLIT_IDX, axis=-1)
        o_fox = _forgetting_attention(fq.reshape(B, S, FOX_HEADS, FOX_HEAD_DIM),
                                      fk.reshape(B, S, FOX_HEADS, FOX_HEAD_DIM),
                                      fv.reshape(B, S, FOX_HEADS, FOX_HEAD_DIM),
                                      flog, b_f[l])
        o_swa = _sliding_window_attention(sq.reshape(B, S, SWA_Q_HEADS, SWA_HEAD_DIM),
                                          sk.reshape(B, S, SWA_KV_HEADS, SWA_HEAD_DIM),
                                          sv.reshape(B, S, SWA_KV_HEADS, SWA_HEAD_DIM),
                                          attn_sinks[l])
        y_fox = (o_fox * jax.nn.silu(g_fox)) @ w_br_fox[l]
        y_swa = (o_swa * jax.nn.silu(g_swa)) @ w_br_swa[l]
        merged = jax.nn.sigmoid(m_fox) * y_fox + jax.nn.sigmoid(m_swa) * y_swa
        sub = merged @ w_out[l]
        z = DEEPNORM_ALPHA * x + gate[:, None, :] * sub
        x = _layer_norm(z) * ln_g[l] + ln_b[l]
    return x
```

```cpp
#include <hip/hip_runtime.h>
#include <hip/hip_cooperative_groups.h>
#include <cstdio>
#include <cstdint>
#include <cmath>
namespace cg = cooperative_groups;
namespace pg8 {
#define PG8_LAS __attribute__((address_space(3)))
typedef unsigned short bf16_t;
typedef short bf16x8 __attribute__((ext_vector_type(8)));
typedef float f32x4 __attribute__((ext_vector_type(4)));
typedef unsigned u32x4 __attribute__((ext_vector_type(4)));
constexpr int BM = 256, BK = 64, HALF = 128, HTB = HALF * BK * 2  , STAGE_BYTES = 8 * HTB, NXCD = 8, WGM = 8;

__host__ __device__ __forceinline__ int lds_byte(int r, int c) { const int st = (r >> 4) * 2 + (c >> 5), rr = r & 15, cc = c & 31, ob = rr * 64 + cc * 2; return st * 1024 + (ob ^ (((ob >> 9) & 1) << 5)); }
__host__ __device__ __forceinline__ void stage_rc(int b, int& R, int& C) { const int st = b / 1024, sb = b % 1024, swz = sb ^ (((sb >> 9) & 1) << 5); R = (st >> 1) * 16 + swz / 64; C = (st & 1) * 32 + (swz % 64) / 2; }
__host__ __device__ __forceinline__ int perm32(int rho) { const int n = rho >> 4, i = rho & 15; return 8 * (i >> 2) + 4 * n + (i & 3); }

struct Unit { int pm, pn; };
struct Gemm { const bf16_t* A; const bf16_t* Bt; int M, N, K; };

struct StaticOrder {
    int nM, nN, nwg, G, c;
    __host__ __device__ void init(int M, int N, int G_, int c_) { nM = M / BM; nN = N / BM; nwg = nM * nN; G = G_; c = c_; }
    __host__ __device__ bool next(int i, Unit& u) const {
        const long L = (long)i * G + c; if (L >= nwg) return false;
        int wgid = (int)L; { const int q = nwg / NXCD, r = nwg % NXCD, xcd = wgid % NXCD, off = wgid / NXCD; wgid = (xcd < r ? xcd * (q + 1) : r * (q + 1) + (xcd - r) * q) + off; }
        const int nig = WGM * nN, gid = wgid / nig, fm = gid * WGM, gsz = (nM - fm) < WGM ? (nM - fm) : WGM;
        u.pm = fm + ((wgid % nig) % gsz); u.pn = (wgid % nig) / gsz; return true;
    }
    __device__ __forceinline__ void a_ready(const Unit&) const {}
    __device__ __forceinline__ void done(const Unit&) const {}
};

__device__ __forceinline__ unsigned cvt_pk_bf16(float lo, float hi) { unsigned r; asm volatile("v_cvt_pk_bf16_f32 %0, %1, %2" : "=v"(r) : "v"(lo), "v"(hi)); return r; }
typedef float f32x2 __attribute__((ext_vector_type(2)));

typedef unsigned u32x4e __attribute__((ext_vector_type(4)));
__device__ __forceinline__ float bf_lo(unsigned w) { return __builtin_bit_cast(float, w << 16); }
__device__ __forceinline__ float bf_hi(unsigned w) { return __builtin_bit_cast(float, w & 0xffff0000u); }
__device__ __forceinline__ float sigmoidf_fast(float x) { return __builtin_amdgcn_rcpf(1.0f + __builtin_amdgcn_exp2f(-1.4426950408889634f * x)); }
constexpr int LDP = 10752;
constexpr int C_FQ = 0, C_FK = 1024, C_FV = 2048, C_SQ = 3072, C_SK = 4096, C_SV = 4352, C_GF = 4608, C_GS = 5632, C_MF = 6656, C_MS = 8704;
constexpr float QS_FOX = 0.08838834764831845f * 1.4426950408889634f;
constexpr float QS_SWA = 0.125f * 1.4426950408889634f;

struct EpiProj {
    static constexpr bool PERM = true, AFTER_DRAIN = false;
    bf16_t* O;
    __device__ __forceinline__ void operator()(const f32x4 (&acc)[2][2][4][2], const Unit& u, int wr, int wc, int fr, int fq) const {
        const int pn = u.pn;
        int mode = 0; float sc = 1.f;
        if (pn < 4) sc = QS_FOX; else if (pn >= 12 && pn < 16) sc = QS_SWA; else if (pn >= 18 && pn < 26) mode = 1; else if (pn >= 26) mode = 2;
        const int row0 = u.pm * BM + wr * 64 + fr; const int col0 = pn * BM + wc * 32 + 8 * fq;
#pragma unroll
        for (int ai = 0; ai < 2; ++ai)
#pragma unroll
            for (int m = 0; m < 4; ++m) { bf16_t* rowp = O + (size_t)(row0 + ai * HALF + m * 16) * LDP + col0;
#pragma unroll
                for (int bj = 0; bj < 2; ++bj) { f32x4 v0 = acc[ai][bj][m][0], v1 = acc[ai][bj][m][1];
                    if (mode == 0) { v0 = v0 * sc; v1 = v1 * sc; }
                    else {
#pragma unroll
                        for (int e = 0; e < 4; ++e) { const float s0 = sigmoidf_fast(v0[e]), s1 = sigmoidf_fast(v1[e]); v0[e] = (mode == 1) ? v0[e] * s0 : s0; v1[e] = (mode == 1) ? v1[e] * s1 : s1; }
                    }
                    u32x4e w; w.x = cvt_pk_bf16(v0[0], v0[1]); w.y = cvt_pk_bf16(v0[2], v0[3]); w.z = cvt_pk_bf16(v1[0], v1[1]); w.w = cvt_pk_bf16(v1[2], v1[3]);
                    *(u32x4e*)(rowp + bj * HALF) = w; } }
    }
};
struct EpiPartial {
    static constexpr bool PERM = true, AFTER_DRAIN = false;
    float* part; const bf16_t* sig;
    __device__ __forceinline__ void operator()(const f32x4 (&acc)[2][2][4][2], const Unit& u, int wr, int wc, int fr, int fq) const {
        const int row0 = u.pm * BM + wr * 64 + fr; const int col0 = u.pn * BM + wc * 32 + 8 * fq;
#pragma unroll
        for (int ai = 0; ai < 2; ++ai)
#pragma unroll
            for (int m = 0; m < 4; ++m) { const size_t r = (size_t)(row0 + ai * HALF + m * 16);
#pragma unroll
                for (int bj = 0; bj < 2; ++bj) { const int c = col0 + bj * HALF;
                    const u32x4e s = *(const u32x4e*)(sig + r * LDP + c);
                    f32x4 v0 = acc[ai][bj][m][0], v1 = acc[ai][bj][m][1];
                    v0[0] *= bf_lo(s.x); v0[1] *= bf_hi(s.x); v0[2] *= bf_lo(s.y); v0[3] *= bf_hi(s.y);
                    v1[0] *= bf_lo(s.z); v1[1] *= bf_hi(s.z); v1[2] *= bf_lo(s.w); v1[3] *= bf_hi(s.w);
                    float* p = part + r * 2048 + c; *(f32x4*)p = v0; *(f32x4*)(p + 4) = v1; }
                asm volatile("" ::: "memory"); }
    }
};
struct EpiMerge {
    static constexpr bool PERM = true, AFTER_DRAIN = false;
    const float* part; const bf16_t* sig; bf16_t* O;
    __device__ __forceinline__ void operator()(const f32x4 (&acc)[2][2][4][2], const Unit& u, int wr, int wc, int fr, int fq) const {
        const int row0 = u.pm * BM + wr * 64 + fr; const int col0 = u.pn * BM + wc * 32 + 8 * fq;
#pragma unroll
        for (int ai = 0; ai < 2; ++ai)
#pragma unroll
            for (int m = 0; m < 4; ++m) { const size_t r = (size_t)(row0 + ai * HALF + m * 16);
#pragma unroll
                for (int bj = 0; bj < 2; ++bj) { const int c = col0 + bj * HALF;
                    const u32x4e s = *(const u32x4e*)(sig + r * LDP + c);
                    const float* p = part + r * 2048 + c; const f32x4 p0 = *(const f32x4*)p, p1 = *(const f32x4*)(p + 4);
                    f32x4 v0 = acc[ai][bj][m][0], v1 = acc[ai][bj][m][1];
                    v0[0] = p0[0] + v0[0] * bf_lo(s.x); v0[1] = p0[1] + v0[1] * bf_hi(s.x); v0[2] = p0[2] + v0[2] * bf_lo(s.y); v0[3] = p0[3] + v0[3] * bf_hi(s.y);
                    v1[0] = p1[0] + v1[0] * bf_lo(s.z); v1[1] = p1[1] + v1[1] * bf_hi(s.z); v1[2] = p1[2] + v1[2] * bf_lo(s.w); v1[3] = p1[3] + v1[3] * bf_hi(s.w);
                    u32x4e w; w.x = cvt_pk_bf16(v0[0], v0[1]); w.y = cvt_pk_bf16(v0[2], v0[3]); w.z = cvt_pk_bf16(v1[0], v1[1]); w.w = cvt_pk_bf16(v1[2], v1[3]);
                    *(u32x4e*)(O + r * 2048 + c) = w; }
                asm volatile("" ::: "memory"); }
    }
};
struct EpiZ {
    static constexpr bool PERM = true, AFTER_DRAIN = false;
    const float* x; const float* gate; float* z; float alpha;
    __device__ __forceinline__ void operator()(const f32x4 (&acc)[2][2][4][2], const Unit& u, int wr, int wc, int fr, int fq) const {
        const int row0 = u.pm * BM + wr * 64 + fr; const int col0 = u.pn * BM + wc * 32 + 8 * fq;
#pragma unroll
        for (int bj = 0; bj < 2; ++bj) { const int c = col0 + bj * HALF;
            const f32x4 g0 = *(const f32x4*)(gate + c), g1 = *(const f32x4*)(gate + c + 4);
#pragma unroll
            for (int ai = 0; ai < 2; ++ai)
#pragma unroll
                for (int m = 0; m < 4; ++m) { const size_t r = (size_t)(row0 + ai * HALF + m * 16);
                    const float* xp = x + r * 2048 + c; const f32x4 x0 = *(const f32x4*)xp, x1 = *(const f32x4*)(xp + 4);
                    const f32x4 v0 = x0 * alpha + g0 * acc[ai][bj][m][0], v1 = x1 * alpha + g1 * acc[ai][bj][m][1];
                    float* zp = z + r * 2048 + c; *(f32x4*)zp = v0; *(f32x4*)(zp + 4) = v1;
                    asm volatile("" ::: "memory"); } }
    }
};

template <class Epi, class Sched, bool ALIGN_EPI = false, bool SP2 = false>
__device__ __forceinline__ void gemm_phase(PG8_LAS unsigned char* lds, const Gemm g, const Sched& S, const Epi& E) {
    const int tid = threadIdx.x, wid = __builtin_amdgcn_readfirstlane(tid >> 6), lane = tid & 63, wr = wid >> 2, wc = wid & 3, fr = lane & 15, fq = lane >> 4;
    const int K = g.K, nt = K / BK;
    unsigned voffA[2], voffB[2];
#pragma unroll
    for (int i = 0; i < 2; ++i) { int R, C; stage_rc(tid * 16 + i * 8192, R, C); const int Rb = Epi::PERM ? ((R & ~31) + perm32(R & 31)) : R;
        voffA[i] = (unsigned)(R * K + C) * 2u; voffB[i] = (unsigned)(Rb * K + C) * 2u; }
    const size_t kstep = (size_t)(BK * 2);
    const size_t hstep = (size_t)HALF * K * 2;
    const size_t tstep = 2 * hstep;
    const unsigned ldsw = (unsigned)wid * 1024u;
    const int aoff = lds_byte(wr * 64 + fr, fq * 8), boff = lds_byte(wc * 32 + fr, fq * 8);
#define PG8_SA(b, h) (((b) * 2 + (h)) * HTB)
#define PG8_SB(b, h) ((4 + (b) * 2 + (h)) * HTB)
#define PG8_STAGE(bufoff, gbase, voff) do { _Pragma("unroll") for (int _i = 0; _i < 2; ++_i) \
        __builtin_amdgcn_global_load_lds((const unsigned*)((const char*)(gbase) + (voff)[_i]), (PG8_LAS unsigned*)(lds + (bufoff) + ldsw + _i * 8192), 16, 0, 0); } while (0)
#define PG8_LDA(dst, b, h) do { _Pragma("unroll") for (int m = 0; m < 4; ++m) _Pragma("unroll") for (int k = 0; k < 2; ++k) dst[m][k] = *(const PG8_LAS bf16x8*)(lds + PG8_SA(b, h) + aoff + m * 2048 + k * 1024); } while (0)
#define PG8_LDB(dst, b, h) do { _Pragma("unroll") for (int n = 0; n < 2; ++n) _Pragma("unroll") for (int k = 0; k < 2; ++k) dst[n][k] = *(const PG8_LAS bf16x8*)(lds + PG8_SB(b, h) + boff + n * 2048 + k * 1024); } while (0)
#define PG8_MMA(ai, bj, At, Bt) do { __builtin_amdgcn_s_setprio(1); _Pragma("unroll") for (int m = 0; m < 4; ++m) _Pragma("unroll") for (int n = 0; n < 2; ++n) _Pragma("unroll") for (int k = 0; k < 2; ++k) \
        acc[ai][bj][m][n] = __builtin_amdgcn_mfma_f32_16x16x32_bf16(Bt[n][k], At[m][k], acc[ai][bj][m][n], 0, 0, 0); __builtin_amdgcn_s_setprio(0); } while (0)
#define PG8_WAIT_V(n) asm volatile("s_waitcnt vmcnt(" #n ")" ::: "memory")
#define PG8_WAIT_L(n) asm volatile("s_waitcnt lgkmcnt(" #n ")" ::: "memory")
#define PG8_BAR __builtin_amdgcn_s_barrier()
#define PG8_SCHED __builtin_amdgcn_sched_barrier(0)
    Unit cur, nxt; int ui = 0;
    if (!S.next(0, cur)) return;
    f32x4 acc[2][2][4][2];
#pragma unroll
    for (int a = 0; a < 2; ++a)
#pragma unroll
        for (int b = 0; b < 2; ++b)
#pragma unroll
            for (int m = 0; m < 4; ++m)
#pragma unroll
                for (int n = 0; n < 2; ++n) acc[a][b][m][n] = (f32x4){0.f, 0.f, 0.f, 0.f};
    bf16x8 At[4][2], B0[2][2], B1[2][2];
    const char* cA = (const char*)g.A + (size_t)cur.pm * tstep; const char* cB = (const char*)g.Bt + (size_t)cur.pn * tstep;
    S.a_ready(cur);
    if constexpr (SP2) {
        PG8_STAGE(PG8_SB(0, 0), cB, voffB); PG8_STAGE(PG8_SB(0, 1), cB + hstep, voffB); PG8_STAGE(PG8_SA(0, 0), cA, voffA); PG8_STAGE(PG8_SA(0, 1), cA + hstep, voffA);
        if (wr == 1) PG8_BAR;
        PG8_WAIT_V(2); PG8_BAR;
        PG8_STAGE(PG8_SB(1, 0), cB + kstep, voffB); PG8_STAGE(PG8_SA(1, 0), cA + kstep, voffA); PG8_STAGE(PG8_SB(1, 1), cB + hstep + kstep, voffB);
        PG8_WAIT_V(6); PG8_BAR;
    } else {
        PG8_STAGE(PG8_SB(0, 0), cB, voffB); PG8_STAGE(PG8_SA(0, 0), cA, voffA); PG8_STAGE(PG8_SB(0, 1), cB + hstep, voffB); PG8_STAGE(PG8_SA(0, 1), cA + hstep, voffA);
        if (wr == 1) PG8_BAR;
        PG8_WAIT_V(4); PG8_BAR;
        PG8_STAGE(PG8_SB(1, 0), cB + kstep, voffB); PG8_STAGE(PG8_SA(1, 0), cA + kstep, voffA); PG8_STAGE(PG8_SB(1, 1), cB + hstep + kstep, voffB);
        PG8_WAIT_V(6); PG8_BAR;
    }
    for (;;) {
        const bool has_next = S.next(ui + 1, nxt);
        const char* nA = has_next ? (const char*)g.A + (size_t)nxt.pm * tstep : cA; const char* nB = has_next ? (const char*)g.Bt + (size_t)nxt.pn * tstep : cB;
        for (int t = 0; t < nt; t += 2) {
            const bool last = (t == nt - 2);
            const char* a1 = cA + (size_t)(t + 1) * kstep;
            const char* a2 = last ? nA : cA + (size_t)(t + 2) * kstep; const char* b2 = last ? nB : cB + (size_t)(t + 2) * kstep;
            const char* a3 = a2 + kstep; const char* b3 = b2 + kstep;
            if (last && has_next) S.a_ready(nxt);
            if constexpr (SP2) {
            PG8_LDB(B0, 0, 0); PG8_LDB(B1, 0, 1); PG8_SCHED; PG8_LDA(At, 0, 0); PG8_STAGE(PG8_SA(1, 1), a1 + hstep, voffA);
            PG8_WAIT_V(8); PG8_WAIT_L(0); PG8_BAR; PG8_MMA(0, 0, At, B0); PG8_MMA(0, 1, At, B1); PG8_BAR; PG8_SCHED;
            PG8_LDA(At, 0, 1); PG8_STAGE(PG8_SB(0, 0), b2, voffB); PG8_STAGE(PG8_SB(0, 1), b2 + hstep, voffB); PG8_STAGE(PG8_SA(0, 0), a2, voffA);
            PG8_WAIT_V(8); PG8_WAIT_L(0); PG8_BAR; PG8_MMA(1, 0, At, B0); PG8_MMA(1, 1, At, B1); PG8_BAR; PG8_SCHED;
            PG8_LDB(B0, 1, 0); PG8_LDB(B1, 1, 1); PG8_SCHED; PG8_LDA(At, 1, 0); PG8_STAGE(PG8_SA(0, 1), a2 + hstep, voffA);
            PG8_WAIT_V(8); PG8_WAIT_L(0); PG8_BAR; PG8_MMA(0, 0, At, B0); PG8_MMA(0, 1, At, B1); PG8_BAR; PG8_SCHED;
            PG8_LDA(At, 1, 1); PG8_STAGE(PG8_SB(1, 0), b3, voffB); PG8_STAGE(PG8_SB(1, 1), b3 + hstep, voffB); PG8_STAGE(PG8_SA(1, 0), a3, voffA);
            PG8_WAIT_V(8); PG8_WAIT_L(0); PG8_BAR; PG8_MMA(1, 0, At, B0); PG8_MMA(1, 1, At, B1); PG8_BAR; PG8_SCHED;
            } else {
            PG8_LDB(B0, 0, 0); PG8_SCHED; PG8_LDA(At, 0, 0); PG8_STAGE(PG8_SA(1, 1), a1 + hstep, voffA);
            PG8_WAIT_L(8); PG8_BAR; PG8_WAIT_L(0); PG8_MMA(0, 0, At, B0); PG8_BAR; PG8_SCHED;
            PG8_LDB(B1, 0, 1); PG8_STAGE(PG8_SB(0, 0), b2, voffB);
            PG8_BAR; PG8_WAIT_L(0); PG8_MMA(0, 1, At, B1); PG8_BAR;
            PG8_LDA(At, 0, 1); PG8_STAGE(PG8_SA(0, 0), a2, voffA);
            PG8_BAR; PG8_WAIT_L(0); PG8_MMA(1, 0, At, B0); PG8_BAR; PG8_SCHED;
            PG8_STAGE(PG8_SB(0, 1), b2 + hstep, voffB);
            PG8_WAIT_V(6); PG8_BAR; PG8_MMA(1, 1, At, B1); PG8_BAR;
            PG8_LDB(B0, 1, 0); PG8_SCHED; PG8_LDA(At, 1, 0); PG8_STAGE(PG8_SA(0, 1), a2 + hstep, voffA);
            PG8_WAIT_L(8); PG8_BAR; PG8_WAIT_L(0); PG8_MMA(0, 0, At, B0); PG8_BAR; PG8_SCHED;
            PG8_LDB(B1, 1, 1); PG8_STAGE(PG8_SB(1, 0), b3, voffB);
            PG8_BAR; PG8_WAIT_L(0); PG8_MMA(0, 1, At, B1); PG8_BAR;
            PG8_LDA(At, 1, 1); PG8_STAGE(PG8_SA(1, 0), a3, voffA);
            PG8_BAR; PG8_WAIT_L(0); PG8_MMA(1, 0, At, B0); PG8_BAR; PG8_SCHED;
            PG8_STAGE(PG8_SB(1, 1), b3 + hstep, voffB);
            PG8_WAIT_V(6); PG8_BAR; PG8_MMA(1, 1, At, B1); PG8_BAR;
            }
        }
        if constexpr (ALIGN_EPI) { if (wr == 0) PG8_BAR; }
        if constexpr (!Epi::AFTER_DRAIN) { E(acc, cur, wr, wc, fr, fq); S.done(cur); }
        if (!has_next) break;
#pragma unroll
        for (int a = 0; a < 2; ++a)
#pragma unroll
            for (int b = 0; b < 2; ++b)
#pragma unroll
                for (int m = 0; m < 4; ++m)
#pragma unroll
                    for (int n = 0; n < 2; ++n) acc[a][b][m][n] = (f32x4){0.f, 0.f, 0.f, 0.f};
        cur = nxt; cA = nA; cB = nB; ++ui;
        if constexpr (ALIGN_EPI) { if (wr == 1) PG8_BAR; }
    }
    PG8_WAIT_V(0);
    if constexpr (!ALIGN_EPI) { if (wr == 0) PG8_BAR; }
    PG8_BAR;
    if constexpr (Epi::AFTER_DRAIN) { E.fused(acc, cur, wr, wc, fr, fq, lds, wid, lane); S.done(cur); }
#undef PG8_SA
#undef PG8_SB
#undef PG8_STAGE
#undef PG8_LDA
#undef PG8_LDB
#undef PG8_MMA
#undef PG8_WAIT_V
#undef PG8_WAIT_L
#undef PG8_BAR
#undef PG8_SCHED
}
}

#define GAS __attribute__((address_space(1)))
#define LAS __attribute__((address_space(3)))
typedef unsigned short bf16;
typedef unsigned v4u __attribute__((ext_vector_type(4)));
typedef unsigned v2u __attribute__((ext_vector_type(2)));
typedef float f32x4 __attribute__((ext_vector_type(4)));
typedef short bf16x8 __attribute__((ext_vector_type(8)));
typedef float f32x16 __attribute__((ext_vector_type(16)));
#define LDS_WAIT() asm volatile("s_waitcnt lgkmcnt(0)" ::: "memory")

constexpr int SEQ = 8192, DM = 2048, NIN = 10760, NWAVES = 8, NTHREADS = 512;
constexpr int LDP = pg8::LDP;
constexpr float LN_EPS = 1e-5f;
constexpr float LOG2E = 1.4426950408889634f;
constexpr float DN_ALPHA = 1.189207115002721f;
constexpr float NEG_BIG = -1e30f;

constexpr size_t MiB = 1u << 20;
constexpr size_t WS_ADA = 0;
constexpr size_t WS_LOGF = 64 * 1024;
constexpr size_t WS_CUM = WS_LOGF + 256 * 1024;
constexpr size_t WS_WIN_T = 1 * MiB;
constexpr size_t WS_WBF_T = 44 * MiB;
constexpr size_t WS_WBS_T = 48 * MiB;
constexpr size_t WS_WOUT_T = 52 * MiB;
constexpr size_t WS_H = 64 * MiB;
constexpr size_t WS_PROJ = 96 * MiB;
constexpr size_t WS_AF = 264 * MiB;
constexpr size_t WS_AS = 280 * MiB;
constexpr size_t WS_END = 296 * MiB;

constexpr int LDS_BYTES = 147456;

__device__ __forceinline__ unsigned f2bf(float f) { unsigned u = __builtin_bit_cast(unsigned, f); return (u + 0x7fffu + ((u >> 16) & 1u)) >> 16; }
__device__ __forceinline__ unsigned pk2(float lo, float hi) { return f2bf(lo) | (f2bf(hi) << 16); }
__device__ __forceinline__ float bf2f(bf16 v) { return __builtin_bit_cast(float, (unsigned)v << 16); }
__device__ __forceinline__ float wave_sum(float v) {
#pragma unroll
    for (int o = 1; o < 64; o <<= 1) v += __shfl_xor(v, o);
    return v;
}
__device__ __forceinline__ float wave_max(float v) {
#pragma unroll
    for (int o = 1; o < 64; o <<= 1) v = fmaxf(v, __shfl_xor(v, o));
    return v;
}

struct Args { const float* in[12]; float* out; unsigned char* ws; int ph_lo, ph_hi; };

__device__ __forceinline__ void p0_transpose_item(const float* W, int K, int ldw, int N, bf16* WT, LAS float* scr, int item, int lane) {
    const int nblk = N / 32, kb = item / nblk, nb = item % nblk, k0 = 64 * kb, n0 = 32 * nb;
#pragma unroll 8
    for (int i = 0; i < 32; ++i) { const int kk = 2 * i + (lane >> 5); scr[kk * 33 + (lane & 31)] = W[(size_t)(k0 + kk) * ldw + n0 + (lane & 31)]; }
    LDS_WAIT(); asm volatile("" ::: "memory");
    const int c = lane & 7;
#pragma unroll
    for (int j = 0; j < 4; ++j) { const int n = (lane >> 3) + 8 * j; const LAS float* s = scr + (8 * c) * 33 + n;
        v4u o; o.x = pk2(s[0 * 33], s[1 * 33]); o.y = pk2(s[2 * 33], s[3 * 33]); o.z = pk2(s[4 * 33], s[5 * 33]); o.w = pk2(s[6 * 33], s[7 * 33]);
        *(v4u*)(WT + (size_t)(n0 + n) * K + k0 + 8 * c) = o; }
    LDS_WAIT(); asm volatile("" ::: "memory");
}

__device__ __forceinline__ void phase0(const Args& a, LAS unsigned char* lds) {
    const int tid = threadIdx.x, lane = tid & 63, wave = tid >> 6, G = gridDim.x;
    const float* c = a.in[1]; const float* w_ada = a.in[2]; const float* b_ada = a.in[3];
    float* ada = (float*)(a.ws + WS_ADA);
    LAS float* red = (LAS float*)lds;
    for (int cb = blockIdx.x; cb < 256; cb += G) {
        const int c4 = tid % 6, ks = tid / 6;
        f32x4 acc = {0.f, 0.f, 0.f, 0.f};
        if (ks < 85) {
            for (int k = ks; k < DM; k += 85) { const f32x4 w = *(const f32x4*)(w_ada + (size_t)k * 6144 + 24 * cb + 4 * c4); acc += w * c[k]; }
            *(LAS f32x4*)(red + ks * 24 + 4 * c4) = acc;
        }
        __syncthreads();
        if (tid < 24) { float s = 0.f; for (int i = 0; i < 85; ++i) s += red[i * 24 + tid]; ada[24 * cb + tid] = s + b_ada[24 * cb + tid]; }
        __syncthreads();
    }
    LAS float* scr = (LAS float*)(lds + wave * 16384);
    const int gw = blockIdx.x * NWAVES + wave, NGW = G * NWAVES;
    const float* w_in = a.in[4];
    constexpr int I_A = (DM / 64) * (3072 / 32), I_B = (DM / 64) * (7680 / 32), I_F = (1024 / 64) * (DM / 32), I_O = (DM / 64) * (DM / 32);
    constexpr int NITEMS = I_A + I_B + 2 * I_F + I_O;
    bf16* win_t = (bf16*)(a.ws + WS_WIN_T);
    for (int it = gw; it < NITEMS; it += NGW) {
        int r = it;
        if (r < I_A) { p0_transpose_item(w_in, DM, NIN, 3072, win_t, scr, r, lane); continue; } r -= I_A;
        if (r < I_B) { p0_transpose_item(w_in + 3080, DM, NIN, 7680, win_t + (size_t)3072 * DM, scr, r, lane); continue; } r -= I_B;
        if (r < I_F) { p0_transpose_item(a.in[7], 1024, DM, DM, (bf16*)(a.ws + WS_WBF_T), scr, r, lane); continue; } r -= I_F;
        if (r < I_F) { p0_transpose_item(a.in[8], 1024, DM, DM, (bf16*)(a.ws + WS_WBS_T), scr, r, lane); continue; } r -= I_F;
        p0_transpose_item(a.in[9], DM, DM, DM, (bf16*)(a.ws + WS_WOUT_T), scr, r, lane);
    }
}

__device__ __forceinline__ void phase1(const Args& a, LAS unsigned char* lds) {
    const int tid = threadIdx.x, lane = tid & 63, wave = tid >> 6, G = gridDim.x;
    const float* x = a.in[0]; const float* w_in = a.in[4]; const float* b_f = a.in[5];
    const float* ada = (const float*)(a.ws + WS_ADA);
    bf16* H = (bf16*)(a.ws + WS_H);
    float* logf_ = (float*)(a.ws + WS_LOGF);
    LAS f32x4* w8 = (LAS f32x4*)lds;
    for (int i = tid; i < 4096; i += NTHREADS) { const int k = i >> 1, half = i & 1; const int l = (k >> 2) & 63, e = k & 3, j = k >> 8;
        w8[((half * 4 + e) * 8 + j) * 64 + l] = *(const f32x4*)(w_in + (size_t)k * NIN + 3072 + 4 * half); }
    __syncthreads();
    const int gw = blockIdx.x * NWAVES + wave, NGW = G * NWAVES;
    for (int m = gw; m < SEQ; m += NGW) {
        const f32x4* xr = (const f32x4*)(x + (size_t)m * DM) + lane;
        f32x4 v[8]; float s = 0.f;
#pragma unroll
        for (int j = 0; j < 8; ++j) { v[j] = xr[64 * j]; s += (v[j].x + v[j].y) + (v[j].z + v[j].w); }
        const float mean = wave_sum(s) * (1.f / DM); float s2 = 0.f;
#pragma unroll
        for (int j = 0; j < 8; ++j) { v[j] = v[j] - mean; s2 += (v[j].x * v[j].x + v[j].y * v[j].y) + (v[j].z * v[j].z + v[j].w * v[j].w); }
        const float rstd = 1.f / sqrtf(wave_sum(s2) * (1.f / DM) + LN_EPS);
        f32x4 al = {0.f, 0.f, 0.f, 0.f}, ah = {0.f, 0.f, 0.f, 0.f};
        v2u* o8 = (v2u*)(H + (size_t)m * DM) + lane;
#pragma unroll
        for (int j = 0; j < 8; ++j) {
            asm volatile("" ::: "memory");
            const f32x4 sh = *((const f32x4*)ada + lane + 64 * j), sc = *((const f32x4*)(ada + DM) + lane + 64 * j);
            const f32x4 hv = v[j] * rstd * (sc + 1.0f) + sh;
            v2u o; o.x = pk2(hv.x, hv.y); o.y = pk2(hv.z, hv.w); o8[64 * j] = o;
#pragma unroll
            for (int e = 0; e < 4; ++e) { const f32x4 wl = w8[((0 + e) * 8 + j) * 64 + lane], wh = w8[((4 + e) * 8 + j) * 64 + lane]; al += wl * hv[e]; ah += wh * hv[e]; }
        }
        float r8[8] = {al.x, al.y, al.z, al.w, ah.x, ah.y, ah.z, ah.w};
#pragma unroll
        for (int hh = 0; hh < 8; ++hh) r8[hh] = wave_sum(r8[hh]);
        if (lane < 8) { float t = r8[0];
#pragma unroll
            for (int hh = 1; hh < 8; ++hh) t = (lane == hh) ? r8[hh] : t;
            const float xx = t + b_f[lane];
            logf_[lane * SEQ + m] = fminf(xx, 0.f) - log1pf(expf(-fabsf(xx))); }
    }
}

__device__ __forceinline__ void scan_head(const Args& a, LAS unsigned char* lds, int h) {
    const int tid = threadIdx.x;
    const float* src = (const float*)(a.ws + WS_LOGF) + (size_t)h * SEQ + 16 * tid;
    float* dst = (float*)(a.ws + WS_CUM) + (size_t)h * SEQ + 16 * tid;
    LAS float* tot = (LAS float*)lds;
    float v[16];
#pragma unroll
    for (int i = 0; i < 4; ++i) { const f32x4 t = *((const f32x4*)src + i); v[4 * i] = t.x; v[4 * i + 1] = t.y; v[4 * i + 2] = t.z; v[4 * i + 3] = t.w; }
#pragma unroll
    for (int i = 1; i < 16; ++i) v[i] += v[i - 1];
    tot[tid] = v[15];
    __syncthreads();
    float base = 0.f;
    for (int i = 0; i < tid; ++i) base += tot[i];
#pragma unroll
    for (int i = 0; i < 4; ++i) { f32x4 t = {v[4 * i] + base, v[4 * i + 1] + base, v[4 * i + 2] + base, v[4 * i + 3] + base}; *((f32x4*)dst + i) = t; }
    __syncthreads();
}

template <bool FOX>
__device__ __forceinline__ void naive_attn(const Args& a, LAS unsigned char* lds) {
    constexpr int D = FOX ? 128 : 64, NH = FOX ? 8 : 16;
    const int tid = threadIdx.x, lane = tid & 63, wave = tid >> 6, G = gridDim.x;
    const bf16* P = (const bf16*)(a.ws + WS_PROJ);
    const float* cum = (const float*)(a.ws + WS_CUM);
    const float* sinks = a.in[6];
    bf16* O = (bf16*)(a.ws + (FOX ? WS_AF : WS_AS));
    LAS float* qs = (LAS float*)(lds + wave * 1024);
    LAS float* ps = qs + 128;
    const int gw = blockIdx.x * NWAVES + wave, NGW = G * NWAVES;
    for (int row = gw; row < SEQ * NH; row += NGW) {
        const int t = row / NH, h = row % NH;
        const int cq = (FOX ? pg8::C_FQ : pg8::C_SQ) + h * D;
        const int ck = FOX ? (pg8::C_FK + h * D) : (pg8::C_SK + (h >> 2) * D);
        const int cv = FOX ? (pg8::C_FV + h * D) : (pg8::C_SV + (h >> 2) * D);
        const int cg = (FOX ? pg8::C_GF : pg8::C_GS) + h * D;
        if (FOX) { qs[2 * lane] = bf2f(P[(size_t)t * LDP + cq + 2 * lane]); qs[2 * lane + 1] = bf2f(P[(size_t)t * LDP + cq + 2 * lane + 1]); }
        else qs[lane] = bf2f(P[(size_t)t * LDP + cq + lane]);
        LDS_WAIT();
        const float Ft = FOX ? cum[h * SEQ + t] : 0.f;
        const float slope2 = FOX ? 0.f : exp2f(-8.0f * (float)(h + 1) / 16.0f) * LOG2E;
        const int lo = FOX ? 0 : (t - 127 > 0 ? t - 127 : 0);
        float mrun = NEG_BIG, l = 0.f, o0 = 0.f, o1 = 0.f;
        for (int s0 = lo; s0 <= t; s0 += 64) {
            const int s = s0 + lane; const bool valid = s <= t;
            float xv = NEG_BIG;
            if (valid) { const bf16* kr = P + (size_t)s * LDP + ck; float dot = 0.f;
                for (int d = 0; d < D; d += 8) { const v4u kk = *(const v4u*)(kr + d);
                    dot += qs[d] * pg8::bf_lo(kk.x) + qs[d + 1] * pg8::bf_hi(kk.x) + qs[d + 2] * pg8::bf_lo(kk.y) + qs[d + 3] * pg8::bf_hi(kk.y)
                         + qs[d + 4] * pg8::bf_lo(kk.z) + qs[d + 5] * pg8::bf_hi(kk.z) + qs[d + 6] * pg8::bf_lo(kk.w) + qs[d + 7] * pg8::bf_hi(kk.w); }
                xv = FOX ? dot + (Ft - cum[h * SEQ + s]) * LOG2E : dot - slope2 * (float)(t - s); }
            const float mx = wave_max(xv), mnew = fmaxf(mrun, mx), alpha = exp2f(mrun - mnew);
            const float p = valid ? exp2f(xv - mnew) : 0.f;
            l = l * alpha + wave_sum(p); o0 *= alpha; o1 *= alpha; mrun = mnew;
            ps[lane] = p; LDS_WAIT();
            const int nj = (t - s0 + 1) < 64 ? (t - s0 + 1) : 64;
            for (int j = 0; j < nj; ++j) { const float pj = ps[j]; const bf16* vr = P + (size_t)(s0 + j) * LDP + cv;
                if (FOX) { const unsigned vv = *(const unsigned*)(vr + 2 * lane); o0 += pj * pg8::bf_lo(vv); o1 += pj * pg8::bf_hi(vv); }
                else o0 += pj * bf2f(vr[lane]); }
            LDS_WAIT();
        }
        if (!FOX) l += exp2f(sinks[h] * LOG2E - mrun);
        const float inv = 1.f / l;
        if (FOX) { const unsigned gg = *(const unsigned*)(P + (size_t)t * LDP + cg + 2 * lane);
            *(unsigned*)(O + (size_t)t * 1024 + h * D + 2 * lane) = pk2(o0 * inv * pg8::bf_lo(gg), o1 * inv * pg8::bf_hi(gg)); }
        else O[(size_t)t * 1024 + h * D + lane] = (bf16)f2bf(o0 * inv * bf2f(P[(size_t)t * LDP + cg + lane]));
    }
}

__device__ __forceinline__ void phase_ln_out(const Args& a) {
    const int tid = threadIdx.x, lane = tid & 63, wave = tid >> 6, G = gridDim.x;
    const float* lng = a.in[10]; const float* lnb = a.in[11];
    const int gw = blockIdx.x * NWAVES + wave, NGW = G * NWAVES;
    for (int m = gw; m < SEQ; m += NGW) {
        f32x4* zr = (f32x4*)(a.out + (size_t)m * DM) + lane;
        f32x4 v[8]; float s = 0.f;
#pragma unroll
        for (int j = 0; j < 8; ++j) { v[j] = zr[64 * j]; s += (v[j].x + v[j].y) + (v[j].z + v[j].w); }
        const float mean = wave_sum(s) * (1.f / DM); float s2 = 0.f;
#pragma unroll
        for (int j = 0; j < 8; ++j) { v[j] = v[j] - mean; s2 += (v[j].x * v[j].x + v[j].y * v[j].y) + (v[j].z * v[j].z + v[j].w * v[j].w); }
        const float rstd = 1.f / sqrtf(wave_sum(s2) * (1.f / DM) + LN_EPS);
#pragma unroll
        for (int j = 0; j < 8; ++j) { const f32x4 g = *((const f32x4*)lng + lane + 64 * j), b = *((const f32x4*)lnb + lane + 64 * j); zr[64 * j] = v[j] * rstd * g + b; }
    }
}

constexpr int N_PHASES = 7;
__global__ void __launch_bounds__(NTHREADS) fwd_megakernel(Args args) {
    extern __shared__ __attribute__((aligned(16))) unsigned char lds_raw[];
    LAS unsigned char* lds = (LAS unsigned char*)lds_raw;
    cg::grid_group grid = cg::this_grid();
    const int lo = args.ph_lo, hi = args.ph_hi;
    const bool one = (lo == 0 && hi == N_PHASES);
#define IN(k) (lo <= (k) && (k) < hi)
#define SEAM() do { if (one) grid.sync(); } while (0)
    unsigned char* ws = args.ws;
    if (IN(0)) { phase0(args, lds); SEAM(); }
    if (IN(1)) { phase1(args, lds); SEAM(); }
    if (IN(2)) {
        if (blockIdx.x < 8) scan_head(args, lds, blockIdx.x);
        pg8::Gemm g{(const pg8::bf16_t*)(ws + WS_H), (const pg8::bf16_t*)(ws + WS_WIN_T), SEQ, LDP, DM};
        pg8::StaticOrder S; S.init(SEQ, LDP, gridDim.x, (int)blockIdx.x);
        pg8::EpiProj E{(pg8::bf16_t*)(ws + WS_PROJ)};
        pg8::gemm_phase<pg8::EpiProj, pg8::StaticOrder, true, true>(lds, g, S, E);
        SEAM();
    }
    if (IN(3)) { naive_attn<true>(args, lds); naive_attn<false>(args, lds); SEAM(); }
    if (IN(4)) {
        pg8::StaticOrder S; S.init(SEQ, DM, gridDim.x, (int)blockIdx.x);
        { pg8::Gemm g{(const pg8::bf16_t*)(ws + WS_AF), (const pg8::bf16_t*)(ws + WS_WBF_T), SEQ, DM, 1024};
          pg8::EpiPartial E{args.out, (const pg8::bf16_t*)(ws + WS_PROJ) + pg8::C_MF};
          pg8::gemm_phase<pg8::EpiPartial, pg8::StaticOrder, true, true>(lds, g, S, E); }
        __syncthreads();
        { pg8::Gemm g{(const pg8::bf16_t*)(ws + WS_AS), (const pg8::bf16_t*)(ws + WS_WBS_T), SEQ, DM, 1024};
          pg8::EpiMerge E{args.out, (const pg8::bf16_t*)(ws + WS_PROJ) + pg8::C_MS, (pg8::bf16_t*)(ws + WS_H)};
          pg8::gemm_phase<pg8::EpiMerge, pg8::StaticOrder, true, true>(lds, g, S, E); }
        SEAM();
    }
    if (IN(5)) {
        pg8::StaticOrder S; S.init(SEQ, DM, gridDim.x, (int)blockIdx.x);
        pg8::Gemm g{(const pg8::bf16_t*)(ws + WS_H), (const pg8::bf16_t*)(ws + WS_WOUT_T), SEQ, DM, DM};
        pg8::EpiZ E{args.in[0], (const float*)(ws + WS_ADA) + 2 * DM, args.out, DN_ALPHA};
        pg8::gemm_phase<pg8::EpiZ, pg8::StaticOrder, true, true>(lds, g, S, E);
        SEAM();
    }
    if (IN(6)) { phase_ln_out(args); }
#undef IN
#undef SEAM
}

#ifndef MK_N_LAUNCHES
#define MK_N_LAUNCHES 1
#endif
extern "C" void kernel_launch(void* const* d_in, const int* in_sizes, int n_in, void* d_out, int out_size, void* d_ws, size_t ws_size, hipStream_t stream) {
    static int grid = 0;
    if (grid == 0) {
        if (n_in != 12 || out_size != SEQ * DM || ws_size < WS_END) { fprintf(stderr, "kernel_launch: unexpected shapes (n_in %d out %d ws %zu)\n", n_in, out_size, ws_size); grid = -1; return; }
        int dev = 0, cus = 0, per_cu = 0;
        hipGetDevice(&dev);
        hipDeviceGetAttribute(&cus, hipDeviceAttributeMultiprocessorCount, dev);
        if (hipFuncSetAttribute((const void*)fwd_megakernel, hipFuncAttributeMaxDynamicSharedMemorySize, LDS_BYTES) != hipSuccess) { fprintf(stderr, "kernel_launch: hipFuncSetAttribute failed\n"); grid = -1; return; }
        if (hipOccupancyMaxActiveBlocksPerMultiprocessor(&per_cu, (const void*)fwd_megakernel, NTHREADS, LDS_BYTES) != hipSuccess || per_cu < 1) { fprintf(stderr, "kernel_launch: occupancy query says %d\n", per_cu); per_cu = 1; }
        (void)hipGetLastError();
        grid = cus * (per_cu > 1 ? 1 : per_cu);
        fprintf(stderr, "kernel_launch: grid %d (cus %d per_cu %d)\n", grid, cus, per_cu);
    }
    if (grid < 0) return;
    Args a{};
    for (int i = 0; i < 12; ++i) a.in[i] = (const float*)d_in[i];
    a.out = (float*)d_out; a.ws = (unsigned char*)d_ws;
#if MK_N_LAUNCHES == 1
    a.ph_lo = 0; a.ph_hi = N_PHASES;
    void* kargs[] = {&a};
    hipError_t e = hipLaunchCooperativeKernel((const void*)fwd_megakernel, dim3(grid), dim3(NTHREADS), kargs, LDS_BYTES, stream);
    if (e != hipSuccess) fprintf(stderr, "cooperative launch failed: %s (grid %d)\n", hipGetErrorString(e), grid);
#else
    for (int p = 0; p < N_PHASES; ++p) { a.ph_lo = p; a.ph_hi = p + 1; hipLaunchKernelGGL(fwd_megakernel, dim3(grid), dim3(NTHREADS), LDS_BYTES, stream, a); }
#endif
}
```

```cpp
#include <hip/hip_runtime.h>
#include <hip/hip_cooperative_groups.h>
#include <cstdio>
#include <cstdint>
#include <cmath>
namespace cg = cooperative_groups;
namespace pg8 {
#define PG8_LAS __attribute__((address_space(3)))
typedef unsigned short bf16_t;
typedef short bf16x8 __attribute__((ext_vector_type(8)));
typedef float f32x4 __attribute__((ext_vector_type(4)));
typedef unsigned u32x4 __attribute__((ext_vector_type(4)));
constexpr int BM = 256, BK = 64, HALF = 128, HTB = HALF * BK * 2  , STAGE_BYTES = 8 * HTB, NXCD = 8, WGM = 8;

__host__ __device__ __forceinline__ int lds_byte(int r, int c) { const int st = (r >> 4) * 2 + (c >> 5), rr = r & 15, cc = c & 31, ob = rr * 64 + cc * 2; return st * 1024 + (ob ^ (((ob >> 9) & 1) << 5)); }
__host__ __device__ __forceinline__ void stage_rc(int b, int& R, int& C) { const int st = b / 1024, sb = b % 1024, swz = sb ^ (((sb >> 9) & 1) << 5); R = (st >> 1) * 16 + swz / 64; C = (st & 1) * 32 + (swz % 64) / 2; }
__host__ __device__ __forceinline__ int perm32(int rho) { const int n = rho >> 4, i = rho & 15; return 8 * (i >> 2) + 4 * n + (i & 3); }

struct Unit { int pm, pn; };
struct Gemm { const bf16_t* A; const bf16_t* Bt; int M, N, K; };

struct StaticOrder {
    int nM, nN, nwg, G, c;
    __host__ __device__ void init(int M, int N, int G_, int c_) { nM = M / BM; nN = N / BM; nwg = nM * nN; G = G_; c = c_; }
    __host__ __device__ bool next(int i, Unit& u) const {
        const long L = (long)i * G + c; if (L >= nwg) return false;
        int wgid = (int)L; { const int q = nwg / NXCD, r = nwg % NXCD, xcd = wgid % NXCD, off = wgid / NXCD; wgid = (xcd < r ? xcd * (q + 1) : r * (q + 1) + (xcd - r) * q) + off; }
        const int nig = WGM * nN, gid = wgid / nig, fm = gid * WGM, gsz = (nM - fm) < WGM ? (nM - fm) : WGM;
        u.pm = fm + ((wgid % nig) % gsz); u.pn = (wgid % nig) / gsz; return true;
    }
    __device__ __forceinline__ void a_ready(const Unit&) const {}
    __device__ __forceinline__ void done(const Unit&) const {}
};

__device__ __forceinline__ unsigned cvt_pk_bf16(float lo, float hi) { unsigned r; asm volatile("v_cvt_pk_bf16_f32 %0, %1, %2" : "=v"(r) : "v"(lo), "v"(hi)); return r; }
typedef float f32x2 __attribute__((ext_vector_type(2)));

typedef unsigned u32x4e __attribute__((ext_vector_type(4)));
__device__ __forceinline__ float bf_lo(unsigned w) { return __builtin_bit_cast(float, w << 16); }
__device__ __forceinline__ float bf_hi(unsigned w) { return __builtin_bit_cast(float, w & 0xffff0000u); }
__device__ __forceinline__ float sigmoidf_fast(float x) { return __builtin_amdgcn_rcpf(1.0f + __builtin_amdgcn_exp2f(-1.4426950408889634f * x)); }
constexpr int LDP = 10752;
constexpr int C_FQ = 0, C_FK = 1024, C_FV = 2048, C_SQ = 3072, C_SK = 4096, C_SV = 4352, C_GF = 4608, C_GS = 5632, C_MF = 6656, C_MS = 8704;
constexpr float QS_FOX = 0.08838834764831845f * 1.4426950408889634f;
constexpr float QS_SWA = 0.125f * 1.4426950408889634f;

struct EpiProj {
    static constexpr bool PERM = true, AFTER_DRAIN = false;
    bf16_t* O;
    __device__ __forceinline__ void operator()(const f32x4 (&acc)[2][2][4][2], const Unit& u, int wr, int wc, int fr, int fq) const {
        const int pn = u.pn;
        int mode = 0; float sc = 1.f;
        if (pn < 4) sc = QS_FOX; else if (pn >= 12 && pn < 16) sc = QS_SWA; else if (pn >= 18 && pn < 26) mode = 1; else if (pn >= 26) mode = 2;
        const int row0 = u.pm * BM + wr * 64 + fr; const int col0 = pn * BM + wc * 32 + 8 * fq;
#pragma unroll
        for (int ai = 0; ai < 2; ++ai)
#pragma unroll
            for (int m = 0; m < 4; ++m) { bf16_t* rowp = O + (size_t)(row0 + ai * HALF + m * 16) * LDP + col0;
#pragma unroll
                for (int bj = 0; bj < 2; ++bj) { f32x4 v0 = acc[ai][bj][m][0], v1 = acc[ai][bj][m][1];
                    if (mode == 0) { v0 = v0 * sc; v1 = v1 * sc; }
                    else {
#pragma unroll
                        for (int e = 0; e < 4; ++e) { const float s0 = sigmoidf_fast(v0[e]), s1 = sigmoidf_fast(v1[e]); v0[e] = (mode == 1) ? v0[e] * s0 : s0; v1[e] = (mode == 1) ? v1[e] * s1 : s1; }
                    }
                    u32x4e w; w.x = cvt_pk_bf16(v0[0], v0[1]); w.y = cvt_pk_bf16(v0[2], v0[3]); w.z = cvt_pk_bf16(v1[0], v1[1]); w.w = cvt_pk_bf16(v1[2], v1[3]);
                    *(u32x4e*)(rowp + bj * HALF) = w; } }
    }
};
struct EpiPartial {
    static constexpr bool PERM = true, AFTER_DRAIN = false;
    float* part; const bf16_t* sig;
    __device__ __forceinline__ void operator()(const f32x4 (&acc)[2][2][4][2], const Unit& u, int wr, int wc, int fr, int fq) const {
        const int row0 = u.pm * BM + wr * 64 + fr; const int col0 = u.pn * BM + wc * 32 + 8 * fq;
#pragma unroll
        for (int ai = 0; ai < 2; ++ai)
#pragma unroll
            for (int m = 0; m < 4; ++m) { const size_t r = (size_t)(row0 + ai * HALF + m * 16);
#pragma unroll
                for (int bj = 0; bj < 2; ++bj) { const int c = col0 + bj * HALF;
                    const u32x4e s = *(const u32x4e*)(sig + r * LDP + c);
                    f32x4 v0 = acc[ai][bj][m][0], v1 = acc[ai][bj][m][1];
                    v0[0] *= bf_lo(s.x); v0[1] *= bf_hi(s.x); v0[2] *= bf_lo(s.y); v0[3] *= bf_hi(s.y);
                    v1[0] *= bf_lo(s.z); v1[1] *= bf_hi(s.z); v1[2] *= bf_lo(s.w); v1[3] *= bf_hi(s.w);
                    float* p = part + r * 2048 + c; *(f32x4*)p = v0; *(f32x4*)(p + 4) = v1; }
                asm volatile("" ::: "memory"); }
    }
};
struct EpiMerge {
    static constexpr bool PERM = true, AFTER_DRAIN = false;
    const float* part; const bf16_t* sig; bf16_t* O;
    __device__ __forceinline__ void operator()(const f32x4 (&acc)[2][2][4][2], const Unit& u, int wr, int wc, int fr, int fq) const {
        const int row0 = u.pm * BM + wr * 64 + fr; const int col0 = u.pn * BM + wc * 32 + 8 * fq;
#pragma unroll
        for (int ai = 0; ai < 2; ++ai)
#pragma unroll
            for (int m = 0; m < 4; ++m) { const size_t r = (size_t)(row0 + ai * HALF + m * 16);
#pragma unroll
                for (int bj = 0; bj < 2; ++bj) { const int c = col0 + bj * HALF;
                    const u32x4e s = *(const u32x4e*)(sig + r * LDP + c);
                    const float* p = part + r * 2048 + c; const f32x4 p0 = *(const f32x4*)p, p1 = *(const f32x4*)(p + 4);
                    f32x4 v0 = acc[ai][bj][m][0], v1 = acc[ai][bj][m][1];
                    v0[0] = p0[0] + v0[0] * bf_lo(s.x); v0[1] = p0[1] + v0[1] * bf_hi(s.x); v0[2] = p0[2] + v0[2] * bf_lo(s.y); v0[3] = p0[3] + v0[3] * bf_hi(s.y);
                    v1[0] = p1[0] + v1[0] * bf_lo(s.z); v1[1] = p1[1] + v1[1] * bf_hi(s.z); v1[2] = p1[2] + v1[2] * bf_lo(s.w); v1[3] = p1[3] + v1[3] * bf_hi(s.w);
                    u32x4e w; w.x = cvt_pk_bf16(v0[0], v0[1]); w.y = cvt_pk_bf16(v0[2], v0[3]); w.z = cvt_pk_bf16(v1[0], v1[1]); w.w = cvt_pk_bf16(v1[2], v1[3]);
                    *(u32x4e*)(O + r * 2048 + c) = w; }
                asm volatile("" ::: "memory"); }
    }
};
struct EpiZ {
    static constexpr bool PERM = true, AFTER_DRAIN = false;
    const float* x; const float* gate; float* z; float alpha;
    __device__ __forceinline__ void operator()(const f32x4 (&acc)[2][2][4][2], const Unit& u, int wr, int wc, int fr, int fq) const {
        const int row0 = u.pm * BM + wr * 64 + fr; const int col0 = u.pn * BM + wc * 32 + 8 * fq;
#pragma unroll
        for (int bj = 0; bj < 2; ++bj) { const int c = col0 + bj * HALF;
            const f32x4 g0 = *(const f32x4*)(gate + c), g1 = *(const f32x4*)(gate + c + 4);
#pragma unroll
            for (int ai = 0; ai < 2; ++ai)
#pragma unroll
                for (int m = 0; m < 4; ++m) { const size_t r = (size_t)(row0 + ai * HALF + m * 16);
                    const float* xp = x + r * 2048 + c; const f32x4 x0 = *(const f32x4*)xp, x1 = *(const f32x4*)(xp + 4);
                    const f32x4 v0 = x0 * alpha + g0 * acc[ai][bj][m][0], v1 = x1 * alpha + g1 * acc[ai][bj][m][1];
                    float* zp = z + r * 2048 + c; *(f32x4*)zp = v0; *(f32x4*)(zp + 4) = v1;
                    asm volatile("" ::: "memory"); } }
    }
};

template <class Epi, class Sched, bool ALIGN_EPI = false, bool SP2 = false>
__device__ __forceinline__ void gemm_phase(PG8_LAS unsigned char* lds, const Gemm g, const Sched& S, const Epi& E) {
    const int tid = threadIdx.x, wid = __builtin_amdgcn_readfirstlane(tid >> 6), lane = tid & 63, wr = wid >> 2, wc = wid & 3, fr = lane & 15, fq = lane >> 4;
    const int K = g.K, nt = K / BK;
    unsigned voffA[2], voffB[2];
#pragma unroll
    for (int i = 0; i < 2; ++i) { int R, C; stage_rc(tid * 16 + i * 8192, R, C); const int Rb = Epi::PERM ? ((R & ~31) + perm32(R & 31)) : R;
        voffA[i] = (unsigned)(R * K + C) * 2u; voffB[i] = (unsigned)(Rb * K + C) * 2u; }
    const size_t kstep = (size_t)(BK * 2);
    const size_t hstep = (size_t)HALF * K * 2;
    const size_t tstep = 2 * hstep;
    const unsigned ldsw = (unsigned)wid * 1024u;
    const int aoff = lds_byte(wr * 64 + fr, fq * 8), boff = lds_byte(wc * 32 + fr, fq * 8);
#define PG8_SA(b, h) (((b) * 2 + (h)) * HTB)
#define PG8_SB(b, h) ((4 + (b) * 2 + (h)) * HTB)
#define PG8_STAGE(bufoff, gbase, voff) do { _Pragma("unroll") for (int _i = 0; _i < 2; ++_i) \
        __builtin_amdgcn_global_load_lds((const unsigned*)((const char*)(gbase) + (voff)[_i]), (PG8_LAS unsigned*)(lds + (bufoff) + ldsw + _i * 8192), 16, 0, 0); } while (0)
#define PG8_LDA(dst, b, h) do { _Pragma("unroll") for (int m = 0; m < 4; ++m) _Pragma("unroll") for (int k = 0; k < 2; ++k) dst[m][k] = *(const PG8_LAS bf16x8*)(lds + PG8_SA(b, h) + aoff + m * 2048 + k * 1024); } while (0)
#define PG8_LDB(dst, b, h) do { _Pragma("unroll") for (int n = 0; n < 2; ++n) _Pragma("unroll") for (int k = 0; k < 2; ++k) dst[n][k] = *(const PG8_LAS bf16x8*)(lds + PG8_SB(b, h) + boff + n * 2048 + k * 1024); } while (0)
#define PG8_MMA(ai, bj, At, Bt) do { __builtin_amdgcn_s_setprio(1); _Pragma("unroll") for (int m = 0; m < 4; ++m) _Pragma("unroll") for (int n = 0; n < 2; ++n) _Pragma("unroll") for (int k = 0; k < 2; ++k) \
        acc[ai][bj][m][n] = __builtin_amdgcn_mfma_f32_16x16x32_bf16(Bt[n][k], At[m][k], acc[ai][bj][m][n], 0, 0, 0); __builtin_amdgcn_s_setprio(0); } while (0)
#define PG8_WAIT_V(n) asm volatile("s_waitcnt vmcnt(" #n ")" ::: "memory")
#define PG8_WAIT_L(n) asm volatile("s_waitcnt lgkmcnt(" #n ")" ::: "memory")
#define PG8_BAR __builtin_amdgcn_s_barrier()
#define PG8_SCHED __builtin_amdgcn_sched_barrier(0)
    Unit cur, nxt; int ui = 0;
    if (!S.next(0, cur)) return;
    f32x4 acc[2][2][4][2];
#pragma unroll
    for (int a = 0; a < 2; ++a)
#pragma unroll
        for (int b = 0; b < 2; ++b)
#pragma unroll
            for (int m = 0; m < 4; ++m)
#pragma unroll
                for (int n = 0; n < 2; ++n) acc[a][b][m][n] = (f32x4){0.f, 0.f, 0.f, 0.f};
    bf16x8 At[4][2], B0[2][2], B1[2][2];
    const char* cA = (const char*)g.A + (size_t)cur.pm * tstep; const char* cB = (const char*)g.Bt + (size_t)cur.pn * tstep;
    S.a_ready(cur);
    if constexpr (SP2) {
        PG8_STAGE(PG8_SB(0, 0), cB, voffB); PG8_STAGE(PG8_SB(0, 1), cB + hstep, voffB); PG8_STAGE(PG8_SA(0, 0), cA, voffA); PG8_STAGE(PG8_SA(0, 1), cA + hstep, voffA);
        if (wr == 1) PG8_BAR;
        PG8_WAIT_V(2); PG8_BAR;
        PG8_STAGE(PG8_SB(1, 0), cB + kstep, voffB); PG8_STAGE(PG8_SA(1, 0), cA + kstep, voffA); PG8_STAGE(PG8_SB(1, 1), cB + hstep + kstep, voffB);
        PG8_WAIT_V(6); PG8_BAR;
    } else {
        PG8_STAGE(PG8_SB(0, 0), cB, voffB); PG8_STAGE(PG8_SA(0, 0), cA, voffA); PG8_STAGE(PG8_SB(0, 1), cB + hstep, voffB); PG8_STAGE(PG8_SA(0, 1), cA + hstep, voffA);
        if (wr == 1) PG8_BAR;
        PG8_WAIT_V(4); PG8_BAR;
        PG8_STAGE(PG8_SB(1, 0), cB + kstep, voffB); PG8_STAGE(PG8_SA(1, 0), cA + kstep, voffA); PG8_STAGE(PG8_SB(1, 1), cB + hstep + kstep, voffB);
        PG8_WAIT_V(6); PG8_BAR;
    }
    for (;;) {
        const bool has_next = S.next(ui + 1, nxt);
        const char* nA = has_next ? (const char*)g.A + (size_t)nxt.pm * tstep : cA; const char* nB = has_next ? (const char*)g.Bt + (size_t)nxt.pn * tstep : cB;
        for (int t = 0; t < nt; t += 2) {
            const bool last = (t == nt - 2);
            const char* a1 = cA + (size_t)(t + 1) * kstep;
            const char* a2 = last ? nA : cA + (size_t)(t + 2) * kstep; const char* b2 = last ? nB : cB + (size_t)(t + 2) * kstep;
            const char* a3 = a2 + kstep; const char* b3 = b2 + kstep;
            if (last && has_next) S.a_ready(nxt);
            if constexpr (SP2) {
            PG8_LDB(B0, 0, 0); PG8_LDB(B1, 0, 1); PG8_SCHED; PG8_LDA(At, 0, 0); PG8_STAGE(PG8_SA(1, 1), a1 + hstep, voffA);
            PG8_WAIT_V(8); PG8_WAIT_L(0); PG8_BAR; PG8_MMA(0, 0, At, B0); PG8_MMA(0, 1, At, B1); PG8_BAR; PG8_SCHED;
            PG8_LDA(At, 0, 1); PG8_STAGE(PG8_SB(0, 0), b2, voffB); PG8_STAGE(PG8_SB(0, 1), b2 + hstep, voffB); PG8_STAGE(PG8_SA(0, 0), a2, voffA);
            PG8_WAIT_V(8); PG8_WAIT_L(0); PG8_BAR; PG8_MMA(1, 0, At, B0); PG8_MMA(1, 1, At, B1); PG8_BAR; PG8_SCHED;
            PG8_LDB(B0, 1, 0); PG8_LDB(B1, 1, 1); PG8_SCHED; PG8_LDA(At, 1, 0); PG8_STAGE(PG8_SA(0, 1), a2 + hstep, voffA);
            PG8_WAIT_V(8); PG8_WAIT_L(0); PG8_BAR; PG8_MMA(0, 0, At, B0); PG8_MMA(0, 1, At, B1); PG8_BAR; PG8_SCHED;
            PG8_LDA(At, 1, 1); PG8_STAGE(PG8_SB(1, 0), b3, voffB); PG8_STAGE(PG8_SB(1, 1), b3 + hstep, voffB); PG8_STAGE(PG8_SA(1, 0), a3, voffA);
            PG8_WAIT_V(8); PG8_WAIT_L(0); PG8_BAR; PG8_MMA(1, 0, At, B0); PG8_MMA(1, 1, At, B1); PG8_BAR; PG8_SCHED;
            } else {
            PG8_LDB(B0, 0, 0); PG8_SCHED; PG8_LDA(At, 0, 0); PG8_STAGE(PG8_SA(1, 1), a1 + hstep, voffA);
            PG8_WAIT_L(8); PG8_BAR; PG8_WAIT_L(0); PG8_MMA(0, 0, At, B0); PG8_BAR; PG8_SCHED;
            PG8_LDB(B1, 0, 1); PG8_STAGE(PG8_SB(0, 0), b2, voffB);
            PG8_BAR; PG8_WAIT_L(0); PG8_MMA(0, 1, At, B1); PG8_BAR;
            PG8_LDA(At, 0, 1); PG8_STAGE(PG8_SA(0, 0), a2, voffA);
            PG8_BAR; PG8_WAIT_L(0); PG8_MMA(1, 0, At, B0); PG8_BAR; PG8_SCHED;
            PG8_STAGE(PG8_SB(0, 1), b2 + hstep, voffB);
            PG8_WAIT_V(6); PG8_BAR; PG8_MMA(1, 1, At, B1); PG8_BAR;
            PG8_LDB(B0, 1, 0); PG8_SCHED; PG8_LDA(At, 1, 0); PG8_STAGE(PG8_SA(0, 1), a2 + hstep, voffA);
            PG8_WAIT_L(8); PG8_BAR; PG8_WAIT_L(0); PG8_MMA(0, 0, At, B0); PG8_BAR; PG8_SCHED;
            PG8_LDB(B1, 1, 1); PG8_STAGE(PG8_SB(1, 0), b3, voffB);
            PG8_BAR; PG8_WAIT_L(0); PG8_MMA(0, 1, At, B1); PG8_BAR;
            PG8_LDA(At, 1, 1); PG8_STAGE(PG8_SA(1, 0), a3, voffA);
            PG8_BAR; PG8_WAIT_L(0); PG8_MMA(1, 0, At, B0); PG8_BAR; PG8_SCHED;
            PG8_STAGE(PG8_SB(1, 1), b3 + hstep, voffB);
            PG8_WAIT_V(6); PG8_BAR; PG8_MMA(1, 1, At, B1); PG8_BAR;
            }
        }
        if constexpr (ALIGN_EPI) { if (wr == 0) PG8_BAR; }
        if constexpr (!Epi::AFTER_DRAIN) { E(acc, cur, wr, wc, fr, fq); S.done(cur); }
        if (!has_next) break;
#pragma unroll
        for (int a = 0; a < 2; ++a)
#pragma unroll
            for (int b = 0; b < 2; ++b)
#pragma unroll
                for (int m = 0; m < 4; ++m)
#pragma unroll
                    for (int n = 0; n < 2; ++n) acc[a][b][m][n] = (f32x4){0.f, 0.f, 0.f, 0.f};
        cur = nxt; cA = nA; cB = nB; ++ui;
        if constexpr (ALIGN_EPI) { if (wr == 1) PG8_BAR; }
    }
    PG8_WAIT_V(0);
    if constexpr (!ALIGN_EPI) { if (wr == 0) PG8_BAR; }
    PG8_BAR;
    if constexpr (Epi::AFTER_DRAIN) { E.fused(acc, cur, wr, wc, fr, fq, lds, wid, lane); S.done(cur); }
#undef PG8_SA
#undef PG8_SB
#undef PG8_STAGE
#undef PG8_LDA
#undef PG8_LDB
#undef PG8_MMA
#undef PG8_WAIT_V
#undef PG8_WAIT_L
#undef PG8_BAR
#undef PG8_SCHED
}
}

#define GAS __attribute__((address_space(1)))
#define LAS __attribute__((address_space(3)))
typedef unsigned short bf16;
typedef unsigned v4u __attribute__((ext_vector_type(4)));
typedef unsigned v2u __attribute__((ext_vector_type(2)));
typedef float f32x4 __attribute__((ext_vector_type(4)));
typedef short bf16x8 __attribute__((ext_vector_type(8)));
typedef float f32x16 __attribute__((ext_vector_type(16)));
#define LDS_WAIT() asm volatile("s_waitcnt lgkmcnt(0)" ::: "memory")

constexpr int SEQ = 8192, DM = 2048, NIN = 10760, NWAVES = 8, NTHREADS = 512;
constexpr int LDP = pg8::LDP;
constexpr float LN_EPS = 1e-5f;
constexpr float LOG2E = 1.4426950408889634f;
constexpr float DN_ALPHA = 1.189207115002721f;
constexpr float NEG_BIG = -1e30f;

constexpr size_t MiB = 1u << 20;
constexpr size_t WS_ADA = 0;
constexpr size_t WS_LOGF = 64 * 1024;
constexpr size_t WS_CUM = WS_LOGF + 256 * 1024;
constexpr size_t WS_WIN_T = 1 * MiB;
constexpr size_t WS_WBF_T = 44 * MiB;
constexpr size_t WS_WBS_T = 48 * MiB;
constexpr size_t WS_WOUT_T = 52 * MiB;
constexpr size_t WS_H = 64 * MiB;
constexpr size_t WS_PROJ = 96 * MiB;
constexpr size_t WS_AF = 264 * MiB;
constexpr size_t WS_AS = 280 * MiB;
constexpr size_t WS_END = 296 * MiB;

constexpr int LDS_BYTES = 147456;

__device__ __forceinline__ unsigned f2bf(float f) { unsigned u = __builtin_bit_cast(unsigned, f); return (u + 0x7fffu + ((u >> 16) & 1u)) >> 16; }
__device__ __forceinline__ unsigned pk2(float lo, float hi) { return f2bf(lo) | (f2bf(hi) << 16); }
__device__ __forceinline__ float bf2f(bf16 v) { return __builtin_bit_cast(float, (unsigned)v << 16); }
__device__ __forceinline__ float wave_sum(float v) {
#pragma unroll
    for (int o = 1; o < 64; o <<= 1) v += __shfl_xor(v, o);
    return v;
}
__device__ __forceinline__ float wave_max(float v) {
#pragma unroll
    for (int o = 1; o < 64; o <<= 1) v = fmaxf(v, __shfl_xor(v, o));
    return v;
}

struct Args { const float* in[12]; float* out; unsigned char* ws; int ph_lo, ph_hi; };

__device__ __forceinline__ void p0_transpose_item(const float* W, int K, int ldw, int N, bf16* WT, LAS float* scr, int item, int lane) {
    const int nblk = N / 32, kb = item / nblk, nb = item % nblk, k0 = 64 * kb, n0 = 32 * nb;
#pragma unroll 8
    for (int i = 0; i < 32; ++i) { const int kk = 2 * i + (lane >> 5); scr[kk * 33 + (lane & 31)] = W[(size_t)(k0 + kk) * ldw + n0 + (lane & 31)]; }
    LDS_WAIT(); asm volatile("" ::: "memory");
    const int c = lane & 7;
#pragma unroll
    for (int j = 0; j < 4; ++j) { const int n = (lane >> 3) + 8 * j; const LAS float* s = scr + (8 * c) * 33 + n;
        v4u o; o.x = pk2(s[0 * 33], s[1 * 33]); o.y = pk2(s[2 * 33], s[3 * 33]); o.z = pk2(s[4 * 33], s[5 * 33]); o.w = pk2(s[6 * 33], s[7 * 33]);
        *(v4u*)(WT + (size_t)(n0 + n) * K + k0 + 8 * c) = o; }
    LDS_WAIT(); asm volatile("" ::: "memory");
}

__device__ __forceinline__ void phase0(const Args& a, LAS unsigned char* lds) {
    const int tid = threadIdx.x, lane = tid & 63, wave = tid >> 6, G = gridDim.x;
    const float* c = a.in[1]; const float* w_ada = a.in[2]; const float* b_ada = a.in[3];
    float* ada = (float*)(a.ws + WS_ADA);
    LAS float* red = (LAS float*)lds;
    for (int cb = blockIdx.x; cb < 256; cb += G) {
        const int c4 = tid % 6, ks = tid / 6;
        f32x4 acc = {0.f, 0.f, 0.f, 0.f};
        if (ks < 85) {
            for (int k = ks; k < DM; k += 85) { const f32x4 w = *(const f32x4*)(w_ada + (size_t)k * 6144 + 24 * cb + 4 * c4); acc += w * c[k]; }
            *(LAS f32x4*)(red + ks * 24 + 4 * c4) = acc;
        }
        __syncthreads();
        if (tid < 24) { float s = 0.f; for (int i = 0; i < 85; ++i) s += red[i * 24 + tid]; ada[24 * cb + tid] = s + b_ada[24 * cb + tid]; }
        __syncthreads();
    }
    LAS float* scr = (LAS float*)(lds + wave * 16384);
    const int gw = blockIdx.x * NWAVES + wave, NGW = G * NWAVES;
    const float* w_in = a.in[4];
    constexpr int I_A = (DM / 64) * (3072 / 32), I_B = (DM / 64) * (7680 / 32), I_F = (1024 / 64) * (DM / 32), I_O = (DM / 64) * (DM / 32);
    constexpr int NITEMS = I_A + I_B + 2 * I_F + I_O;
    bf16* win_t = (bf16*)(a.ws + WS_WIN_T);
    for (int it = gw; it < NITEMS; it += NGW) {
        int r = it;
        if (r < I_A) { p0_transpose_item(w_in, DM, NIN, 3072, win_t, scr, r, lane); continue; } r -= I_A;
        if (r < I_B) { p0_transpose_item(w_in + 3080, DM, NIN, 7680, win_t + (size_t)3072 * DM, scr, r, lane); continue; } r -= I_B;
        if (r < I_F) { p0_transpose_item(a.in[7], 1024, DM, DM, (bf16*)(a.ws + WS_WBF_T), scr, r, lane); continue; } r -= I_F;
        if (r < I_F) { p0_transpose_item(a.in[8], 1024, DM, DM, (bf16*)(a.ws + WS_WBS_T), scr, r, lane); continue; } r -= I_F;
        p0_transpose_item(a.in[9], DM, DM, DM, (bf16*)(a.ws + WS_WOUT_T), scr, r, lane);
    }
}

__device__ __forceinline__ void phase1(const Args& a, LAS unsigned char* lds) {
    const int tid = threadIdx.x, lane = tid & 63, wave = tid >> 6, G = gridDim.x;
    const float* x = a.in[0]; const float* w_in = a.in[4]; const float* b_f = a.in[5];
    const float* ada = (const float*)(a.ws + WS_ADA);
    bf16* H = (bf16*)(a.ws + WS_H);
    float* logf_ = (float*)(a.ws + WS_LOGF);
    LAS f32x4* w8 = (LAS f32x4*)lds;
    for (int i = tid; i < 4096; i += NTHREADS) { const int k = i >> 1, half = i & 1; const int l = (k >> 2) & 63, e = k & 3, j = k >> 8;
        w8[((half * 4 + e) * 8 + j) * 64 + l] = *(const f32x4*)(w_in + (size_t)k * NIN + 3072 + 4 * half); }
    __syncthreads();
    const int gw = blockIdx.x * NWAVES + wave, NGW = G * NWAVES;
    for (int m = gw; m < SEQ; m += NGW) {
        const f32x4* xr = (const f32x4*)(x + (size_t)m * DM) + lane;
        f32x4 v[8]; float s = 0.f;
#pragma unroll
        for (int j = 0; j < 8; ++j) { v[j] = xr[64 * j]; s += (v[j].x + v[j].y) + (v[j].z + v[j].w); }
        const float mean = wave_sum(s) * (1.f / DM); float s2 = 0.f;
#pragma unroll
        for (int j = 0; j < 8; ++j) { v[j] = v[j] - mean; s2 += (v[j].x * v[j].x + v[j].y * v[j].y) + (v[j].z * v[j].z + v[j].w * v[j].w); }
        const float rstd = 1.f / sqrtf(wave_sum(s2) * (1.f / DM) + LN_EPS);
        f32x4 al = {0.f, 0.f, 0.f, 0.f}, ah = {0.f, 0.f, 0.f, 0.f};
        v2u* o8 = (v2u*)(H + (size_t)m * DM) + lane;
#pragma unroll
        for (int j = 0; j < 8; ++j) {
            asm volatile("" ::: "memory");
            const f32x4 sh = *((const f32x4*)ada + lane + 64 * j), sc = *((const f32x4*)(ada + DM) + lane + 64 * j);
            const f32x4 hv = v[j] * rstd * (sc + 1.0f) + sh;
            v2u o; o.x = pk2(hv.x, hv.y); o.y = pk2(hv.z, hv.w); o8[64 * j] = o;
#pragma unroll
            for (int e = 0; e < 4; ++e) { const f32x4 wl = w8[((0 + e) * 8 + j) * 64 + lane], wh = w8[((4 + e) * 8 + j) * 64 + lane]; al += wl * hv[e]; ah += wh * hv[e]; }
        }
        float r8[8] = {al.x, al.y, al.z, al.w, ah.x, ah.y, ah.z, ah.w};
#pragma unroll
        for (int hh = 0; hh < 8; ++hh) r8[hh] = wave_sum(r8[hh]);
        if (lane < 8) { float t = r8[0];
#pragma unroll
            for (int hh = 1; hh < 8; ++hh) t = (lane == hh) ? r8[hh] : t;
            const float xx = t + b_f[lane];
            logf_[lane * SEQ + m] = fminf(xx, 0.f) - log1pf(expf(-fabsf(xx))); }
    }
}

__device__ __forceinline__ void scan_head(const Args& a, LAS unsigned char* lds, int h) {
    const int tid = threadIdx.x;
    const float* src = (const float*)(a.ws + WS_LOGF) + (size_t)h * SEQ + 16 * tid;
    float* dst = (float*)(a.ws + WS_CUM) + (size_t)h * SEQ + 16 * tid;
    LAS float* tot = (LAS float*)lds;
    float v[16];
#pragma unroll
    for (int i = 0; i < 4; ++i) { const f32x4 t = *((const f32x4*)src + i); v[4 * i] = t.x; v[4 * i + 1] = t.y; v[4 * i + 2] = t.z; v[4 * i + 3] = t.w; }
#pragma unroll
    for (int i = 1; i < 16; ++i) v[i] += v[i - 1];
    tot[tid] = v[15];
    __syncthreads();
    float base = 0.f;
    for (int i = 0; i < tid; ++i) base += tot[i];
#pragma unroll
    for (int i = 0; i < 4; ++i) { f32x4 t = {v[4 * i] + base, v[4 * i + 1] + base, v[4 * i + 2] + base, v[4 * i + 3] + base}; *((f32x4*)dst + i) = t; }
    __syncthreads();
}

template <bool FOX>
__device__ __forceinline__ void naive_attn(const Args& a, LAS unsigned char* lds) {
    constexpr int D = FOX ? 128 : 64, NH = FOX ? 8 : 16;
    const int tid = threadIdx.x, lane = tid & 63, wave = tid >> 6, G = gridDim.x;
    const bf16* P = (const bf16*)(a.ws + WS_PROJ);
    const float* cum = (const float*)(a.ws + WS_CUM);
    const float* sinks = a.in[6];
    bf16* O = (bf16*)(a.ws + (FOX ? WS_AF : WS_AS));
    LAS float* qs = (LAS float*)(lds + wave * 1024);
    LAS float* ps = qs + 128;
    const int gw = blockIdx.x * NWAVES + wave, NGW = G * NWAVES;
    for (int row = gw; row < SEQ * NH; row += NGW) {
        const int t = row / NH, h = row % NH;
        const int cq = (FOX ? pg8::C_FQ : pg8::C_SQ) + h * D;
        const int ck = FOX ? (pg8::C_FK + h * D) : (pg8::C_SK + (h >> 2) * D);
        const int cv = FOX ? (pg8::C_FV + h * D) : (pg8::C_SV + (h >> 2) * D);
        const int cg = (FOX ? pg8::C_GF : pg8::C_GS) + h * D;
        if (FOX) { qs[2 * lane] = bf2f(P[(size_t)t * LDP + cq + 2 * lane]); qs[2 * lane + 1] = bf2f(P[(size_t)t * LDP + cq + 2 * lane + 1]); }
        else qs[lane] = bf2f(P[(size_t)t * LDP + cq + lane]);
        LDS_WAIT();
        const float Ft = FOX ? cum[h * SEQ + t] : 0.f;
        const float slope2 = FOX ? 0.f : exp2f(-8.0f * (float)(h + 1) / 16.0f) * LOG2E;
        const int lo = FOX ? 0 : (t - 127 > 0 ? t - 127 : 0);
        float mrun = NEG_BIG, l = 0.f, o0 = 0.f, o1 = 0.f;
        for (int s0 = lo; s0 <= t; s0 += 64) {
            const int s = s0 + lane; const bool valid = s <= t;
            float xv = NEG_BIG;
            if (valid) { const bf16* kr = P + (size_t)s * LDP + ck; float dot = 0.f;
                for (int d = 0; d < D; d += 8) { const v4u kk = *(const v4u*)(kr + d);
                    dot += qs[d] * pg8::bf_lo(kk.x) + qs[d + 1] * pg8::bf_hi(kk.x) + qs[d + 2] * pg8::bf_lo(kk.y) + qs[d + 3] * pg8::bf_hi(kk.y)
                         + qs[d + 4] * pg8::bf_lo(kk.z) + qs[d + 5] * pg8::bf_hi(kk.z) + qs[d + 6] * pg8::bf_lo(kk.w) + qs[d + 7] * pg8::bf_hi(kk.w); }
                xv = FOX ? dot + (Ft - cum[h * SEQ + s]) * LOG2E : dot - slope2 * (float)(t - s); }
            const float mx = wave_max(xv), mnew = fmaxf(mrun, mx), alpha = exp2f(mrun - mnew);
            const float p = valid ? exp2f(xv - mnew) : 0.f;
            l = l * alpha + wave_sum(p); o0 *= alpha; o1 *= alpha; mrun = mnew;
            ps[lane] = p; LDS_WAIT();
            const int nj = (t - s0 + 1) < 64 ? (t - s0 + 1) : 64;
            for (int j = 0; j < nj; ++j) { const float pj = ps[j]; const bf16* vr = P + (size_t)(s0 + j) * LDP + cv;
                if (FOX) { const unsigned vv = *(const unsigned*)(vr + 2 * lane); o0 += pj * pg8::bf_lo(vv); o1 += pj * pg8::bf_hi(vv); }
                else o0 += pj * bf2f(vr[lane]); }
            LDS_WAIT();
        }
        if (!FOX) l += exp2f(sinks[h] * LOG2E - mrun);
        const float inv = 1.f / l;
        if (FOX) { const unsigned gg = *(const unsigned*)(P + (size_t)t * LDP + cg + 2 * lane);
            *(unsigned*)(O + (size_t)t * 1024 + h * D + 2 * lane) = pk2(o0 * inv * pg8::bf_lo(gg), o1 * inv * pg8::bf_hi(gg)); }
        else O[(size_t)t * 1024 + h * D + lane] = (bf16)f2bf(o0 * inv * bf2f(P[(size_t)t * LDP + cg + lane]));
    }
}

__device__ __forceinline__ void phase_ln_out(const Args& a) {
    const int tid = threadIdx.x, lane = tid & 63, wave = tid >> 6, G = gridDim.x;
    const float* lng = a.in[10]; const float* lnb = a.in[11];
    const int gw = blockIdx.x * NWAVES + wave, NGW = G * NWAVES;
    for (int m = gw; m < SEQ; m += NGW) {
        f32x4* zr = (f32x4*)(a.out + (size_t)m * DM) + lane;
        f32x4 v[8]; float s = 0.f;
#pragma unroll
        for (int j = 0; j < 8; ++j) { v[j] = zr[64 * j]; s += (v[j].x + v[j].y) + (v[j].z + v[j].w); }
        const float mean = wave_sum(s) * (1.f / DM); float s2 = 0.f;
#pragma unroll
        for (int j = 0; j < 8; ++j) { v[j] = v[j] - mean; s2 += (v[j].x * v[j].x + v[j].y * v[j].y) + (v[j].z * v[j].z + v[j].w * v[j].w); }
        const float rstd = 1.f / sqrtf(wave_sum(s2) * (1.f / DM) + LN_EPS);
#pragma unroll
        for (int j = 0; j < 8; ++j) { const f32x4 g = *((const f32x4*)lng + lane + 64 * j), b = *((const f32x4*)lnb + lane + 64 * j); zr[64 * j] = v[j] * rstd * g + b; }
    }
}


typedef short s16x4 __attribute__((ext_vector_type(4)));
typedef short v4i16_t __attribute__((ext_vector_type(4)));
typedef float f32x2_t __attribute__((ext_vector_type(2)));
typedef __bf16 bf16x2_t __attribute__((ext_vector_type(2)));
#define MFMA32(a, b, c) __builtin_amdgcn_mfma_f32_32x32x16_bf16((a), (b), (c), 0, 0, 0)
__device__ __forceinline__ s16x4 vtr(LAS const unsigned char* p) { return __builtin_bit_cast(s16x4, __builtin_amdgcn_ds_read_tr16_b64_v4i16((LAS v4i16_t*)p)); }
__device__ __forceinline__ unsigned cvtpk(float lo, float hi) { f32x2_t v = {lo, hi}; bf16x2_t b = __builtin_convertvector(v, bf16x2_t); return __builtin_bit_cast(unsigned, b); }
__device__ __forceinline__ float xor32_max(float v) { auto rr = __builtin_amdgcn_permlane32_swap(__float_as_uint(v), __float_as_uint(v), false, false); return fmaxf(__uint_as_float(rr[0]), __uint_as_float(rr[1])); }
__device__ __forceinline__ float xor32_sum(float v) { auto rr = __builtin_amdgcn_permlane32_swap(__float_as_uint(v), __float_as_uint(v), false, false); return __uint_as_float(rr[0]) + __uint_as_float(rr[1]); }
__device__ __forceinline__ int crow(int i, int h) { return (i & 3) + 8 * (i >> 2) + 4 * h; }

template <bool FOX> struct AC {
    static constexpr int D = FOX ? 128 : 64, NDS = D / 16, NDB = D / 32;
    static constexpr int KSTR = D * 2 + 16, VSTR = FOX ? 320 : 192;
    static constexpr int OFF_K = 0, OFF_V = 128 * KSTR, OFF_B = OFF_V + 128 * VSTR, END = OFF_B + 512;
    static constexpr int CPR = D / 8, NCH = 128 * CPR / NTHREADS;
    static constexpr int W = FOX ? (1 << 30) : 128;
};

template <bool FOX>
__device__ __forceinline__ bool attn_tileA(LAS const unsigned char* Kb, LAS const float* Bb,
                                           const bf16x8 (&qf)[AC<FOX>::NDS], f32x16 (&oT)[AC<FOX>::NDB], float& m, float& l, bf16x8 (&pf)[2][2],
                                           int ka, int ta, int lane, float slope2) {
    typedef AC<FOX> C;
    const int dmax = ta + 31 - ka, dmin = ta - ka - 63;
    if (dmax < 0 || dmin >= C::W) return false;
    const bool need_mask = (dmin < 0) || (dmax >= C::W);
    const int r = lane & 31, h = lane >> 5;
    f32x16 s0, s1;
    if (FOX) {
#pragma unroll
        for (int g4 = 0; g4 < 4; ++g4) { const f32x4 b0 = *(LAS const f32x4*)(Bb + 8 * g4 + 4 * h), b1 = *(LAS const f32x4*)(Bb + 32 + 8 * g4 + 4 * h);
#pragma unroll
            for (int e = 0; e < 4; ++e) { s0[4 * g4 + e] = b0[e]; s1[4 * g4 + e] = b1[e]; } }
    } else {
#pragma unroll
        for (int i = 0; i < 16; ++i) { s0[i] = 0.f; s1[i] = 0.f; }
    }
    LAS const unsigned char* kp = Kb + r * C::KSTR + h * 16;
#pragma unroll
    for (int ds = 0; ds < C::NDS; ++ds) {
        const bf16x8 k0 = *(LAS const bf16x8*)(kp + ds * 32), k1 = *(LAS const bf16x8*)(kp + 32 * C::KSTR + ds * 32);
        s0 = MFMA32(k0, qf[ds], s0); s1 = MFMA32(k1, qf[ds], s1);
    }
    const int tl = ta + r - ka;
    if (!FOX) {
#pragma unroll
        for (int i = 0; i < 16; ++i) { const float d0 = (float)(tl - crow(i, h)); s0[i] -= slope2 * d0; s1[i] -= slope2 * (d0 - 32.f); }
    }
    if (need_mask) {
#pragma unroll
        for (int i = 0; i < 16; ++i) { const int d0 = tl - crow(i, h), d1 = d0 - 32;
            if (d0 < 0 || d0 >= C::W) s0[i] = -1e30f;
            if (d1 < 0 || d1 >= C::W) s1[i] = -1e30f; }
    }
    float mx = fmaxf(s0[0], s1[0]);
#pragma unroll
    for (int i = 1; i < 16; ++i) mx = fmaxf(mx, fmaxf(s0[i], s1[i]));
    mx = xor32_max(mx);
    const float mnew = fmaxf(m, mx), alpha = __builtin_amdgcn_exp2f(m - mnew);
    m = mnew;
    float ps = 0.f;
#pragma unroll
    for (int i = 0; i < 16; ++i) { s0[i] = __builtin_amdgcn_exp2f(s0[i] - mnew); s1[i] = __builtin_amdgcn_exp2f(s1[i] - mnew); ps += s0[i] + s1[i]; }
    l = l * alpha + ps;
#pragma unroll
    for (int db = 0; db < C::NDB; ++db) oT[db] = oT[db] * alpha;
#pragma unroll
    for (int s = 0; s < 2; ++s) {
        v4u a, b;
        a.x = cvtpk(s0[8 * s], s0[8 * s + 1]); a.y = cvtpk(s0[8 * s + 2], s0[8 * s + 3]); a.z = cvtpk(s0[8 * s + 4], s0[8 * s + 5]); a.w = cvtpk(s0[8 * s + 6], s0[8 * s + 7]);
        b.x = cvtpk(s1[8 * s], s1[8 * s + 1]); b.y = cvtpk(s1[8 * s + 2], s1[8 * s + 3]); b.z = cvtpk(s1[8 * s + 4], s1[8 * s + 5]); b.w = cvtpk(s1[8 * s + 6], s1[8 * s + 7]);
        pf[0][s] = __builtin_bit_cast(bf16x8, a); pf[1][s] = __builtin_bit_cast(bf16x8, b);
    }
    return true;
}
template <bool FOX>
__device__ __forceinline__ void attn_tileB(LAS const unsigned char* Vb, f32x16 (&oT)[AC<FOX>::NDB], const bf16x8 (&pf)[2][2], int lane) {
    typedef AC<FOX> C;
    const int h = lane >> 5;
    const int i16 = lane & 15, qq = i16 >> 2, pp = i16 & 3, blk = (lane >> 4) & 1;
    LAS const unsigned char* vp = Vb + (4 * h + qq) * C::VSTR + (16 * blk + 4 * pp) * 2;
#pragma unroll
    for (int db = 0; db < C::NDB; ++db)
#pragma unroll
        for (int b = 0; b < 2; ++b)
#pragma unroll
            for (int s = 0; s < 2; ++s) {
                const s16x4 lo = vtr(vp + (32 * b + 16 * s) * C::VSTR + 64 * db), hi = vtr(vp + (32 * b + 16 * s + 8) * C::VSTR + 64 * db);
                const bf16x8 va = __builtin_shufflevector(lo, hi, 0, 1, 2, 3, 4, 5, 6, 7);
                oT[db] = MFMA32(va, pf[b][s], oT[db]);
            }
}

template <bool FOX>
__device__ __forceinline__ void stage_load(v4u (&kr)[AC<FOX>::NCH], v4u (&vr)[AC<FOX>::NCH], const bf16* Pk, const bf16* Pv, int key0, int tid) {
    typedef AC<FOX> C;
#pragma unroll
    for (int i = 0; i < C::NCH; ++i) { const int c = tid + NTHREADS * i, row = c / C::CPR, ch = c % C::CPR; const size_t off = (size_t)(key0 + row) * LDP + ch * 8;
        kr[i] = *(const v4u*)(Pk + off); vr[i] = *(const v4u*)(Pv + off); }
}
template <bool FOX>
__device__ __forceinline__ void stage_store(const v4u (&kr)[AC<FOX>::NCH], const v4u (&vr)[AC<FOX>::NCH], LAS unsigned char* lds, int tid) {
    typedef AC<FOX> C;
#pragma unroll
    for (int i = 0; i < C::NCH; ++i) { const int c = tid + NTHREADS * i, row = c / C::CPR, ch = c % C::CPR;
        *(LAS v4u*)(lds + C::OFF_K + row * C::KSTR + ch * 16) = kr[i]; *(LAS v4u*)(lds + C::OFF_V + row * C::VSTR + ch * 16) = vr[i]; }
}

__device__ __forceinline__ void fox_unit(const Args& a, LAS unsigned char* lds, int hd, int qb) {
    typedef AC<true> C;
    const int tid = threadIdx.x, lane = tid & 63, wave = __builtin_amdgcn_readfirstlane(tid >> 6), rg = wave & 3, g = wave >> 2;
    const int r = lane & 31, hh = lane >> 5;
    const bf16* P = (const bf16*)(a.ws + WS_PROJ);
    const bf16* Pq = P + pg8::C_FQ + hd * 128; const bf16* Pk = P + pg8::C_FK + hd * 128; const bf16* Pv = P + pg8::C_FV + hd * 128; const bf16* Pg = P + pg8::C_GF + hd * 128;
    const float* cumh = (const float*)(a.ws + WS_CUM) + (size_t)hd * SEQ;
    bf16* O = (bf16*)(a.ws + WS_AF);
    const int q0 = 128 * qb, tq = q0 + 32 * rg + r;
    bf16x8 qf[C::NDS];
#pragma unroll
    for (int ds = 0; ds < C::NDS; ++ds) qf[ds] = *(const bf16x8*)(Pq + (size_t)tq * LDP + ds * 16 + hh * 8);
    const float Fq0 = cumh[q0];
    f32x16 oT[C::NDB];
#pragma unroll
    for (int db = 0; db < C::NDB; ++db)
#pragma unroll
        for (int i = 0; i < 16; ++i) oT[db][i] = 0.f;
    float m = -1e20f, l = 0.f;
    v4u kr[C::NCH], vr[C::NCH]; float breg = 0.f;
    stage_load<true>(kr, vr, Pk, Pv, 0, tid); if (tid < 128) breg = cumh[tid];
    LAS float* ldsB = (LAS float*)(lds + C::OFF_B);
    for (int s = 0; s <= qb; ++s) {
        __syncthreads();
        stage_store<true>(kr, vr, lds, tid); if (tid < 128) ldsB[tid] = (Fq0 - breg) * LOG2E;
        __syncthreads();
        bf16x8 pf[2][2];
        const bool act = attn_tileA<true>(lds + C::OFF_K + 64 * g * C::KSTR, ldsB + 64 * g, qf, oT, m, l, pf, 128 * s + 64 * g, q0 + 32 * rg, lane, 0.f);
        if (s < qb) { stage_load<true>(kr, vr, Pk, Pv, 128 * (s + 1), tid); if (tid < 128) breg = cumh[128 * (s + 1) + tid]; }
        if (act) attn_tileB<true>(lds + C::OFF_V + 64 * g * C::VSTR, oT, pf, lane);
    }
    __syncthreads();
    LAS float* mg = (LAS float*)lds + rg * (66 * 64) + lane;
    if (g == 1) {
#pragma unroll
        for (int db = 0; db < C::NDB; ++db)
#pragma unroll
            for (int i = 0; i < 16; ++i) mg[(db * 16 + i) * 64] = oT[db][i];
        mg[64 * 64] = m; mg[65 * 64] = l;
    }
    __syncthreads();
    if (g == 0) {
        const float m1 = mg[64 * 64], l1 = mg[65 * 64], mt = fmaxf(m, m1), a0 = __builtin_amdgcn_exp2f(m - mt), a1 = __builtin_amdgcn_exp2f(m1 - mt);
        const float inv = 1.0f / xor32_sum(a0 * l + a1 * l1);
        const float s0 = a0 * inv, s1 = a1 * inv;
#pragma unroll
        for (int db = 0; db < C::NDB; ++db)
#pragma unroll
            for (int g4 = 0; g4 < 4; ++g4) { const int d = 32 * db + 8 * g4 + 4 * hh;
                asm volatile("" ::: "memory");
                const v2u gg = *(const v2u*)(Pg + (size_t)tq * LDP + d);
                const float o0 = (s0 * oT[db][4 * g4] + s1 * mg[(db * 16 + 4 * g4) * 64]) * pg8::bf_lo(gg.x), o1 = (s0 * oT[db][4 * g4 + 1] + s1 * mg[(db * 16 + 4 * g4 + 1) * 64]) * pg8::bf_hi(gg.x);
                const float o2 = (s0 * oT[db][4 * g4 + 2] + s1 * mg[(db * 16 + 4 * g4 + 2) * 64]) * pg8::bf_lo(gg.y), o3 = (s0 * oT[db][4 * g4 + 3] + s1 * mg[(db * 16 + 4 * g4 + 3) * 64]) * pg8::bf_hi(gg.y);
                v2u w; w.x = cvtpk(o0, o1); w.y = cvtpk(o2, o3);
                *(v2u*)(O + (size_t)tq * 1024 + hd * 128 + d) = w; }
    }
}

__device__ __forceinline__ void swa_unit(const Args& a, LAS unsigned char* lds, int nb, int hp) {
    typedef AC<false> C;
    const int tid = threadIdx.x, lane = tid & 63, wave = __builtin_amdgcn_readfirstlane(tid >> 6), rg = wave & 3, g = wave >> 2;
    const int r = lane & 31, hh = lane >> 5;
    const int head = 2 * hp + g, kvh = hp >> 1;
    const bf16* P = (const bf16*)(a.ws + WS_PROJ);
    const bf16* Pq = P + pg8::C_SQ + head * 64; const bf16* Pk = P + pg8::C_SK + kvh * 64; const bf16* Pv = P + pg8::C_SV + kvh * 64; const bf16* Pg = P + pg8::C_GS + head * 64;
    bf16* O = (bf16*)(a.ws + WS_AS);
    const int q0 = 128 * nb, tq = q0 + 32 * rg + r;
    const float slope2 = exp2f(-8.0f * (float)(head + 1) / 16.0f) * LOG2E;
    bf16x8 qf[C::NDS];
#pragma unroll
    for (int ds = 0; ds < C::NDS; ++ds) qf[ds] = *(const bf16x8*)(Pq + (size_t)tq * LDP + ds * 16 + hh * 8);
    f32x16 oT[C::NDB];
#pragma unroll
    for (int db = 0; db < C::NDB; ++db)
#pragma unroll
        for (int i = 0; i < 16; ++i) oT[db][i] = 0.f;
    float m = -1e20f, l = 0.f;
    v4u kr[C::NCH], vr[C::NCH];
    const int sfirst = nb > 0 ? nb - 1 : 0;
    stage_load<false>(kr, vr, Pk, Pv, 128 * sfirst, tid);
    for (int s = sfirst; s <= nb; ++s) {
        __syncthreads();
        stage_store<false>(kr, vr, lds, tid);
        __syncthreads();
        if (s < nb) stage_load<false>(kr, vr, Pk, Pv, 128 * (s + 1), tid);
#pragma unroll 1
        for (int jt = 0; jt < 2; ++jt)
        { bf16x8 pf[2][2];
            if (attn_tileA<false>(lds + C::OFF_K + 64 * jt * C::KSTR, nullptr, qf, oT, m, l, pf, 128 * s + 64 * jt, q0 + 32 * rg, lane, slope2))
                attn_tileB<false>(lds + C::OFF_V + 64 * jt * C::VSTR, oT, pf, lane); }
    }
    const float inv = 1.0f / (xor32_sum(l) + __builtin_amdgcn_exp2f(a.in[6][head] * LOG2E - m));
#pragma unroll
    for (int db = 0; db < C::NDB; ++db)
#pragma unroll
        for (int g4 = 0; g4 < 4; ++g4) { const int d = 32 * db + 8 * g4 + 4 * hh;
            const v2u gg = *(const v2u*)(Pg + (size_t)tq * LDP + d);
            const float o0 = oT[db][4 * g4] * inv * pg8::bf_lo(gg.x), o1 = oT[db][4 * g4 + 1] * inv * pg8::bf_hi(gg.x), o2 = oT[db][4 * g4 + 2] * inv * pg8::bf_lo(gg.y), o3 = oT[db][4 * g4 + 3] * inv * pg8::bf_hi(gg.y);
            v2u w; w.x = cvtpk(o0, o1); w.y = cvtpk(o2, o3);
            *(v2u*)(O + (size_t)tq * 1024 + head * 64 + d) = w; }
}

#ifndef ATTN_FOX_FAST
#define ATTN_FOX_FAST 1
#endif
#ifndef ATTN_SWA_FAST
#define ATTN_SWA_FAST 1
#endif
__device__ __forceinline__ void phase_attn(const Args& a, LAS unsigned char* lds) {
    const int G = gridDim.x;
#if ATTN_FOX_FAST
    for (int p = blockIdx.x; p < 256; p += G) { const int hd = p & 7, j = p >> 3;
#pragma unroll 1
        for (int k = 0; k < 2; ++k) fox_unit(a, lds, hd, k ? j : 63 - j); }
#else
    naive_attn<true>(a, lds);
#endif
    __syncthreads();
#if ATTN_SWA_FAST
    for (int u = blockIdx.x; u < 512; u += G) { const int hp = u & 7, nb = u >> 3; swa_unit(a, lds, nb, hp); }
#else
    naive_attn<false>(a, lds);
#endif
}

constexpr int N_PHASES = 7;
__global__ void __launch_bounds__(NTHREADS) fwd_megakernel(Args args) {
    extern __shared__ __attribute__((aligned(16))) unsigned char lds_raw[];
    LAS unsigned char* lds = (LAS unsigned char*)lds_raw;
    cg::grid_group grid = cg::this_grid();
    const int lo = args.ph_lo, hi = args.ph_hi;
    const bool one = (lo == 0 && hi == N_PHASES);
#define IN(k) (lo <= (k) && (k) < hi)
#define SEAM() do { if (one) grid.sync(); } while (0)
    unsigned char* ws = args.ws;
    if (IN(0)) { phase0(args, lds); SEAM(); }
    if (IN(1)) { phase1(args, lds); SEAM(); }
    if (IN(2)) {
        if (blockIdx.x < 8) scan_head(args, lds, blockIdx.x);
        pg8::Gemm g{(const pg8::bf16_t*)(ws + WS_H), (const pg8::bf16_t*)(ws + WS_WIN_T), SEQ, LDP, DM};
        pg8::StaticOrder S; S.init(SEQ, LDP, gridDim.x, (int)blockIdx.x);
        pg8::EpiProj E{(pg8::bf16_t*)(ws + WS_PROJ)};
        pg8::gemm_phase<pg8::EpiProj, pg8::StaticOrder, true, true>(lds, g, S, E);
        SEAM();
    }
    if (IN(3)) { phase_attn(args, lds); SEAM(); }
    if (IN(4)) {
        pg8::StaticOrder S; S.init(SEQ, DM, gridDim.x, (int)blockIdx.x);
        { pg8::Gemm g{(const pg8::bf16_t*)(ws + WS_AF), (const pg8::bf16_t*)(ws + WS_WBF_T), SEQ, DM, 1024};
          pg8::EpiPartial E{args.out, (const pg8::bf16_t*)(ws + WS_PROJ) + pg8::C_MF};
          pg8::gemm_phase<pg8::EpiPartial, pg8::StaticOrder, true, true>(lds, g, S, E); }
        __syncthreads();
        { pg8::Gemm g{(const pg8::bf16_t*)(ws + WS_AS), (const pg8::bf16_t*)(ws + WS_WBS_T), SEQ, DM, 1024};
          pg8::EpiMerge E{args.out, (const pg8::bf16_t*)(ws + WS_PROJ) + pg8::C_MS, (pg8::bf16_t*)(ws + WS_H)};
          pg8::gemm_phase<pg8::EpiMerge, pg8::StaticOrder, true, true>(lds, g, S, E); }
        SEAM();
    }
    if (IN(5)) {
        pg8::StaticOrder S; S.init(SEQ, DM, gridDim.x, (int)blockIdx.x);
        pg8::Gemm g{(const pg8::bf16_t*)(ws + WS_H), (const pg8::bf16_t*)(ws + WS_WOUT_T), SEQ, DM, DM};
        pg8::EpiZ E{args.in[0], (const float*)(ws + WS_ADA) + 2 * DM, args.out, DN_ALPHA};
        pg8::gemm_phase<pg8::EpiZ, pg8::StaticOrder, true, true>(lds, g, S, E);
        SEAM();
    }
    if (IN(6)) { phase_ln_out(args); }
#undef IN
#undef SEAM
}

#ifndef MK_N_LAUNCHES
#define MK_N_LAUNCHES 1
#endif
extern "C" void kernel_launch(void* const* d_in, const int* in_sizes, int n_in, void* d_out, int out_size, void* d_ws, size_t ws_size, hipStream_t stream) {
    static int grid = 0;
    if (grid == 0) {
        if (n_in != 12 || out_size != SEQ * DM || ws_size < WS_END) { fprintf(stderr, "kernel_launch: unexpected shapes (n_in %d out %d ws %zu)\n", n_in, out_size, ws_size); grid = -1; return; }
        int dev = 0, cus = 0, per_cu = 0;
        hipGetDevice(&dev);
        hipDeviceGetAttribute(&cus, hipDeviceAttributeMultiprocessorCount, dev);
        if (hipFuncSetAttribute((const void*)fwd_megakernel, hipFuncAttributeMaxDynamicSharedMemorySize, LDS_BYTES) != hipSuccess) { fprintf(stderr, "kernel_launch: hipFuncSetAttribute failed\n"); grid = -1; return; }
        if (hipOccupancyMaxActiveBlocksPerMultiprocessor(&per_cu, (const void*)fwd_megakernel, NTHREADS, LDS_BYTES) != hipSuccess || per_cu < 1) { fprintf(stderr, "kernel_launch: occupancy query says %d\n", per_cu); per_cu = 1; }
        (void)hipGetLastError();
        grid = cus * (per_cu > 1 ? 1 : per_cu);
        fprintf(stderr, "kernel_launch: grid %d (cus %d per_cu %d)\n", grid, cus, per_cu);
    }
    if (grid < 0) return;
    Args a{};
    for (int i = 0; i < 12; ++i) a.in[i] = (const float*)d_in[i];
    a.out = (float*)d_out; a.ws = (unsigned char*)d_ws;
#if MK_N_LAUNCHES == 1
    a.ph_lo = 0; a.ph_hi = N_PHASES;
    void* kargs[] = {&a};
    hipError_t e = hipLaunchCooperativeKernel((const void*)fwd_megakernel, dim3(grid), dim3(NTHREADS), kargs, LDS_BYTES, stream);
    if (e != hipSuccess) fprintf(stderr, "cooperative launch failed: %s (grid %d)\n", hipGetErrorString(e), grid);
#else
    for (int p = 0; p < N_PHASES; ++p) { a.ph_lo = p; a.ph_hi = p + 1; hipLaunchKernelGGL(fwd_megakernel, dim3(grid), dim3(NTHREADS), LDS_BYTES, stream, a); }
#endif
}
```

```cpp
#include <hip/hip_runtime.h>
#include <hip/hip_cooperative_groups.h>
#include <cstdio>
#include <cstdint>
#include <cmath>
namespace cg = cooperative_groups;
namespace pg8 {
#define PG8_LAS __attribute__((address_space(3)))
typedef unsigned short bf16_t;
typedef short bf16x8 __attribute__((ext_vector_type(8)));
typedef float f32x4 __attribute__((ext_vector_type(4)));
typedef unsigned u32x4 __attribute__((ext_vector_type(4)));
constexpr int BM = 256, BK = 64, HALF = 128, HTB = HALF * BK * 2  , STAGE_BYTES = 8 * HTB, NXCD = 8, WGM = 8;

__host__ __device__ __forceinline__ int lds_byte(int r, int c) { const int st = (r >> 4) * 2 + (c >> 5), rr = r & 15, cc = c & 31, ob = rr * 64 + cc * 2; return st * 1024 + (ob ^ (((ob >> 9) & 1) << 5)); }
__host__ __device__ __forceinline__ void stage_rc(int b, int& R, int& C) { const int st = b / 1024, sb = b % 1024, swz = sb ^ (((sb >> 9) & 1) << 5); R = (st >> 1) * 16 + swz / 64; C = (st & 1) * 32 + (swz % 64) / 2; }
__host__ __device__ __forceinline__ int perm32(int rho) { const int n = rho >> 4, i = rho & 15; return 8 * (i >> 2) + 4 * n + (i & 3); }

struct Unit { int pm, pn; };
struct Gemm { const bf16_t* A; const bf16_t* Bt; int M, N, K; };

struct StaticOrder {
    int nM, nN, nwg, G, c;
    __host__ __device__ void init(int M, int N, int G_, int c_) { nM = M / BM; nN = N / BM; nwg = nM * nN; G = G_; c = c_; }
    __host__ __device__ bool next(int i, Unit& u) const {
        const long L = (long)i * G + c; if (L >= nwg) return false;
        int wgid = (int)L; { const int q = nwg / NXCD, r = nwg % NXCD, xcd = wgid % NXCD, off = wgid / NXCD; wgid = (xcd < r ? xcd * (q + 1) : r * (q + 1) + (xcd - r) * q) + off; }
        const int nig = WGM * nN, gid = wgid / nig, fm = gid * WGM, gsz = (nM - fm) < WGM ? (nM - fm) : WGM;
        u.pm = fm + ((wgid % nig) % gsz); u.pn = (wgid % nig) / gsz; return true;
    }
    __device__ __forceinline__ void a_ready(const Unit&) const {}
    __device__ __forceinline__ void done(const Unit&) const {}
};

__device__ __forceinline__ unsigned cvt_pk_bf16(float lo, float hi) { unsigned r; asm volatile("v_cvt_pk_bf16_f32 %0, %1, %2" : "=v"(r) : "v"(lo), "v"(hi)); return r; }
typedef float f32x2 __attribute__((ext_vector_type(2)));

typedef unsigned u32x4e __attribute__((ext_vector_type(4)));
__device__ __forceinline__ float bf_lo(unsigned w) { return __builtin_bit_cast(float, w << 16); }
__device__ __forceinline__ float bf_hi(unsigned w) { return __builtin_bit_cast(float, w & 0xffff0000u); }
__device__ __forceinline__ float sigmoidf_fast(float x) { return __builtin_amdgcn_rcpf(1.0f + __builtin_amdgcn_exp2f(-1.4426950408889634f * x)); }
constexpr int LDP = 10752;
constexpr int C_FQ = 0, C_FK = 1024, C_FV = 2048, C_SQ = 3072, C_SK = 4096, C_SV = 4352, C_GF = 4608, C_GS = 5632, C_MF = 6656, C_MS = 8704;
constexpr float QS_FOX = 0.08838834764831845f * 1.4426950408889634f;
constexpr float QS_SWA = 0.125f * 1.4426950408889634f;

struct EpiProj {
    static constexpr bool PERM = true, AFTER_DRAIN = false;
    bf16_t* O;
    __device__ __forceinline__ void operator()(const f32x4 (&acc)[2][2][4][2], const Unit& u, int wr, int wc, int fr, int fq) const {
        const int pn = u.pn;
        int mode = 0; float sc = 1.f;
        if (pn < 4) sc = QS_FOX; else if (pn >= 12 && pn < 16) sc = QS_SWA; else if (pn >= 18 && pn < 26) mode = 1; else if (pn >= 26) mode = 2;
        const int row0 = u.pm * BM + wr * 64 + fr; const int col0 = pn * BM + wc * 32 + 8 * fq;
#pragma unroll
        for (int ai = 0; ai < 2; ++ai)
#pragma unroll
            for (int m = 0; m < 4; ++m) { bf16_t* rowp = O + (size_t)(row0 + ai * HALF + m * 16) * LDP + col0;
#pragma unroll
                for (int bj = 0; bj < 2; ++bj) { f32x4 v0 = acc[ai][bj][m][0], v1 = acc[ai][bj][m][1];
                    if (mode == 0) { v0 = v0 * sc; v1 = v1 * sc; }
                    else {
#pragma unroll
                        for (int e = 0; e < 4; ++e) { const float s0 = sigmoidf_fast(v0[e]), s1 = sigmoidf_fast(v1[e]); v0[e] = (mode == 1) ? v0[e] * s0 : s0; v1[e] = (mode == 1) ? v1[e] * s1 : s1; }
                    }
                    u32x4e w; w.x = cvt_pk_bf16(v0[0], v0[1]); w.y = cvt_pk_bf16(v0[2], v0[3]); w.z = cvt_pk_bf16(v1[0], v1[1]); w.w = cvt_pk_bf16(v1[2], v1[3]);
                    *(u32x4e*)(rowp + bj * HALF) = w; } }
    }
};
struct EpiPartial {
    static constexpr bool PERM = true, AFTER_DRAIN = false;
    float* part; const bf16_t* sig;
    __device__ __forceinline__ void operator()(const f32x4 (&acc)[2][2][4][2], const Unit& u, int wr, int wc, int fr, int fq) const {
        const int row0 = u.pm * BM + wr * 64 + fr; const int col0 = u.pn * BM + wc * 32 + 8 * fq;
#pragma unroll
        for (int ai = 0; ai < 2; ++ai)
#pragma unroll
            for (int m = 0; m < 4; ++m) { const size_t r = (size_t)(row0 + ai * HALF + m * 16);
#pragma unroll
                for (int bj = 0; bj < 2; ++bj) { const int c = col0 + bj * HALF;
                    const u32x4e s = *(const u32x4e*)(sig + r * LDP + c);
                    f32x4 v0 = acc[ai][bj][m][0], v1 = acc[ai][bj][m][1];
                    v0[0] *= bf_lo(s.x); v0[1] *= bf_hi(s.x); v0[2] *= bf_lo(s.y); v0[3] *= bf_hi(s.y);
                    v1[0] *= bf_lo(s.z); v1[1] *= bf_hi(s.z); v1[2] *= bf_lo(s.w); v1[3] *= bf_hi(s.w);
                    float* p = part + r * 2048 + c; *(f32x4*)p = v0; *(f32x4*)(p + 4) = v1; }
                asm volatile("" ::: "memory"); }
    }
};
struct EpiMerge {
    static constexpr bool PERM = true, AFTER_DRAIN = false;
    const float* part; const bf16_t* sig; bf16_t* O;
    __device__ __forceinline__ void operator()(const f32x4 (&acc)[2][2][4][2], const Unit& u, int wr, int wc, int fr, int fq) const {
        const int row0 = u.pm * BM + wr * 64 + fr; const int col0 = u.pn * BM + wc * 32 + 8 * fq;
#pragma unroll
        for (int ai = 0; ai < 2; ++ai)
#pragma unroll
            for (int m = 0; m < 4; ++m) { const size_t r = (size_t)(row0 + ai * HALF + m * 16);
#pragma unroll
                for (int bj = 0; bj < 2; ++bj) { const int c = col0 + bj * HALF;
                    const u32x4e s = *(const u32x4e*)(sig + r * LDP + c);
                    const float* p = part + r * 2048 + c; const f32x4 p0 = *(const f32x4*)p, p1 = *(const f32x4*)(p + 4);
                    f32x4 v0 = acc[ai][bj][m][0], v1 = acc[ai][bj][m][1];
                    v0[0] = p0[0] + v0[0] * bf_lo(s.x); v0[1] = p0[1] + v0[1] * bf_hi(s.x); v0[2] = p0[2] + v0[2] * bf_lo(s.y); v0[3] = p0[3] + v0[3] * bf_hi(s.y);
                    v1[0] = p1[0] + v1[0] * bf_lo(s.z); v1[1] = p1[1] + v1[1] * bf_hi(s.z); v1[2] = p1[2] + v1[2] * bf_lo(s.w); v1[3] = p1[3] + v1[3] * bf_hi(s.w);
                    u32x4e w; w.x = cvt_pk_bf16(v0[0], v0[1]); w.y = cvt_pk_bf16(v0[2], v0[3]); w.z = cvt_pk_bf16(v1[0], v1[1]); w.w = cvt_pk_bf16(v1[2], v1[3]);
                    *(u32x4e*)(O + r * 2048 + c) = w; }
                asm volatile("" ::: "memory"); }
    }
};
struct EpiZ {
    static constexpr bool PERM = true, AFTER_DRAIN = false;
    const float* x; const float* gate; float* z; float alpha;
    __device__ __forceinline__ void operator()(const f32x4 (&acc)[2][2][4][2], const Unit& u, int wr, int wc, int fr, int fq) const {
        const int row0 = u.pm * BM + wr * 64 + fr; const int col0 = u.pn * BM + wc * 32 + 8 * fq;
#pragma unroll
        for (int bj = 0; bj < 2; ++bj) { const int c = col0 + bj * HALF;
            const f32x4 g0 = *(const f32x4*)(gate + c), g1 = *(const f32x4*)(gate + c + 4);
#pragma unroll
            for (int ai = 0; ai < 2; ++ai)
#pragma unroll
                for (int m = 0; m < 4; ++m) { const size_t r = (size_t)(row0 + ai * HALF + m * 16);
                    const float* xp = x + r * 2048 + c; const f32x4 x0 = *(const f32x4*)xp, x1 = *(const f32x4*)(xp + 4);
                    const f32x4 v0 = x0 * alpha + g0 * acc[ai][bj][m][0], v1 = x1 * alpha + g1 * acc[ai][bj][m][1];
                    float* zp = z + r * 2048 + c; *(f32x4*)zp = v0; *(f32x4*)(zp + 4) = v1;
                    asm volatile("" ::: "memory"); } }
    }
};

template <class Epi, class Sched, bool ALIGN_EPI = false, bool SP2 = false>
__device__ __forceinline__ void gemm_phase(PG8_LAS unsigned char* lds, const Gemm g, const Sched& S, const Epi& E) {
    const int tid = threadIdx.x, wid = __builtin_amdgcn_readfirstlane(tid >> 6), lane = tid & 63, wr = wid >> 2, wc = wid & 3, fr = lane & 15, fq = lane >> 4;
    const int K = g.K, nt = K / BK;
    unsigned voffA[2], voffB[2];
#pragma unroll
    for (int i = 0; i < 2; ++i) { int R, C; stage_rc(tid * 16 + i * 8192, R, C); const int Rb = Epi::PERM ? ((R & ~31) + perm32(R & 31)) : R;
        voffA[i] = (unsigned)(R * K + C) * 2u; voffB[i] = (unsigned)(Rb * K + C) * 2u; }
    const size_t kstep = (size_t)(BK * 2);
    const size_t hstep = (size_t)HALF * K * 2;
    const size_t tstep = 2 * hstep;
    const unsigned ldsw = (unsigned)wid * 1024u;
    const int aoff = lds_byte(wr * 64 + fr, fq * 8), boff = lds_byte(wc * 32 + fr, fq * 8);
#define PG8_SA(b, h) (((b) * 2 + (h)) * HTB)
#define PG8_SB(b, h) ((4 + (b) * 2 + (h)) * HTB)
#define PG8_STAGE(bufoff, gbase, voff) do { _Pragma("unroll") for (int _i = 0; _i < 2; ++_i) \
        __builtin_amdgcn_global_load_lds((const unsigned*)((const char*)(gbase) + (voff)[_i]), (PG8_LAS unsigned*)(lds + (bufoff) + ldsw + _i * 8192), 16, 0, 0); } while (0)
#define PG8_LDA(dst, b, h) do { _Pragma("unroll") for (int m = 0; m < 4; ++m) _Pragma("unroll") for (int k = 0; k < 2; ++k) dst[m][k] = *(const PG8_LAS bf16x8*)(lds + PG8_SA(b, h) + aoff + m * 2048 + k * 1024); } while (0)
#define PG8_LDB(dst, b, h) do { _Pragma("unroll") for (int n = 0; n < 2; ++n) _Pragma("unroll") for (int k = 0; k < 2; ++k) dst[n][k] = *(const PG8_LAS bf16x8*)(lds + PG8_SB(b, h) + boff + n * 2048 + k * 1024); } while (0)
#define PG8_MMA(ai, bj, At, Bt) do { __builtin_amdgcn_s_setprio(1); _Pragma("unroll") for (int m = 0; m < 4; ++m) _Pragma("unroll") for (int n = 0; n < 2; ++n) _Pragma("unroll") for (int k = 0; k < 2; ++k) \
        acc[ai][bj][m][n] = __builtin_amdgcn_mfma_f32_16x16x32_bf16(Bt[n][k], At[m][k], acc[ai][bj][m][n], 0, 0, 0); __builtin_amdgcn_s_setprio(0); } while (0)
#define PG8_WAIT_V(n) asm volatile("s_waitcnt vmcnt(" #n ")" ::: "memory")
#define PG8_WAIT_L(n) asm volatile("s_waitcnt lgkmcnt(" #n ")" ::: "memory")
#define PG8_BAR __builtin_amdgcn_s_barrier()
#define PG8_SCHED __builtin_amdgcn_sched_barrier(0)
    Unit cur, nxt; int ui = 0;
    if (!S.next(0, cur)) return;
    f32x4 acc[2][2][4][2];
#pragma unroll
    for (int a = 0; a < 2; ++a)
#pragma unroll
        for (int b = 0; b < 2; ++b)
#pragma unroll
            for (int m = 0; m < 4; ++m)
#pragma unroll
                for (int n = 0; n < 2; ++n) acc[a][b][m][n] = (f32x4){0.f, 0.f, 0.f, 0.f};
    bf16x8 At[4][2], B0[2][2], B1[2][2];
    const char* cA = (const char*)g.A + (size_t)cur.pm * tstep; const char* cB = (const char*)g.Bt + (size_t)cur.pn * tstep;
    S.a_ready(cur);
    if constexpr (SP2) {
        PG8_STAGE(PG8_SB(0, 0), cB, voffB); PG8_STAGE(PG8_SB(0, 1), cB + hstep, voffB); PG8_STAGE(PG8_SA(0, 0), cA, voffA); PG8_STAGE(PG8_SA(0, 1), cA + hstep, voffA);
        if (wr == 1) PG8_BAR;
        PG8_WAIT_V(2); PG8_BAR;
        PG8_STAGE(PG8_SB(1, 0), cB + kstep, voffB); PG8_STAGE(PG8_SA(1, 0), cA + kstep, voffA); PG8_STAGE(PG8_SB(1, 1), cB + hstep + kstep, voffB);
        PG8_WAIT_V(6); PG8_BAR;
    } else {
        PG8_STAGE(PG8_SB(0, 0), cB, voffB); PG8_STAGE(PG8_SA(0, 0), cA, voffA); PG8_STAGE(PG8_SB(0, 1), cB + hstep, voffB); PG8_STAGE(PG8_SA(0, 1), cA + hstep, voffA);
        if (wr == 1) PG8_BAR;
        PG8_WAIT_V(4); PG8_BAR;
        PG8_STAGE(PG8_SB(1, 0), cB + kstep, voffB); PG8_STAGE(PG8_SA(1, 0), cA + kstep, voffA); PG8_STAGE(PG8_SB(1, 1), cB + hstep + kstep, voffB);
        PG8_WAIT_V(6); PG8_BAR;
    }
    for (;;) {
        const bool has_next = S.next(ui + 1, nxt);
        const char* nA = has_next ? (const char*)g.A + (size_t)nxt.pm * tstep : cA; const char* nB = has_next ? (const char*)g.Bt + (size_t)nxt.pn * tstep : cB;
        for (int t = 0; t < nt; t += 2) {
            const bool last = (t == nt - 2);
            const char* a1 = cA + (size_t)(t + 1) * kstep;
            const char* a2 = last ? nA : cA + (size_t)(t + 2) * kstep; const char* b2 = last ? nB : cB + (size_t)(t + 2) * kstep;
            const char* a3 = a2 + kstep; const char* b3 = b2 + kstep;
            if (last && has_next) S.a_ready(nxt);
            if constexpr (SP2) {
            PG8_LDB(B0, 0, 0); PG8_LDB(B1, 0, 1); PG8_SCHED; PG8_LDA(At, 0, 0); PG8_STAGE(PG8_SA(1, 1), a1 + hstep, voffA);
            PG8_WAIT_V(8); PG8_WAIT_L(0); PG8_BAR; PG8_MMA(0, 0, At, B0); PG8_MMA(0, 1, At, B1); PG8_BAR; PG8_SCHED;
            PG8_LDA(At, 0, 1); PG8_STAGE(PG8_SB(0, 0), b2, voffB); PG8_STAGE(PG8_SB(0, 1), b2 + hstep, voffB); PG8_STAGE(PG8_SA(0, 0), a2, voffA);
            PG8_WAIT_V(8); PG8_WAIT_L(0); PG8_BAR; PG8_MMA(1, 0, At, B0); PG8_MMA(1, 1, At, B1); PG8_BAR; PG8_SCHED;
            PG8_LDB(B0, 1, 0); PG8_LDB(B1, 1, 1); PG8_SCHED; PG8_LDA(At, 1, 0); PG8_STAGE(PG8_SA(0, 1), a2 + hstep, voffA);
            PG8_WAIT_V(8); PG8_WAIT_L(0); PG8_BAR; PG8_MMA(0, 0, At, B0); PG8_MMA(0, 1, At, B1); PG8_BAR; PG8_SCHED;
            PG8_LDA(At, 1, 1); PG8_STAGE(PG8_SB(1, 0), b3, voffB); PG8_STAGE(PG8_SB(1, 1), b3 + hstep, voffB); PG8_STAGE(PG8_SA(1, 0), a3, voffA);
            PG8_WAIT_V(8); PG8_WAIT_L(0); PG8_BAR; PG8_MMA(1, 0, At, B0); PG8_MMA(1, 1, At, B1); PG8_BAR; PG8_SCHED;
            } else {
            PG8_LDB(B0, 0, 0); PG8_SCHED; PG8_LDA(At, 0, 0); PG8_STAGE(PG8_SA(1, 1), a1 + hstep, voffA);
            PG8_WAIT_L(8); PG8_BAR; PG8_WAIT_L(0); PG8_MMA(0, 0, At, B0); PG8_BAR; PG8_SCHED;
            PG8_LDB(B1, 0, 1); PG8_STAGE(PG8_SB(0, 0), b2, voffB);
            PG8_BAR; PG8_WAIT_L(0); PG8_MMA(0, 1, At, B1); PG8_BAR;
            PG8_LDA(At, 0, 1); PG8_STAGE(PG8_SA(0, 0), a2, voffA);
            PG8_BAR; PG8_WAIT_L(0); PG8_MMA(1, 0, At, B0); PG8_BAR; PG8_SCHED;
            PG8_STAGE(PG8_SB(0, 1), b2 + hstep, voffB);
            PG8_WAIT_V(6); PG8_BAR; PG8_MMA(1, 1, At, B1); PG8_BAR;
            PG8_LDB(B0, 1, 0); PG8_SCHED; PG8_LDA(At, 1, 0); PG8_STAGE(PG8_SA(0, 1), a2 + hstep, voffA);
            PG8_WAIT_L(8); PG8_BAR; PG8_WAIT_L(0); PG8_MMA(0, 0, At, B0); PG8_BAR; PG8_SCHED;
            PG8_LDB(B1, 1, 1); PG8_STAGE(PG8_SB(1, 0), b3, voffB);
            PG8_BAR; PG8_WAIT_L(0); PG8_MMA(0, 1, At, B1); PG8_BAR;
            PG8_LDA(At, 1, 1); PG8_STAGE(PG8_SA(1, 0), a3, voffA);
            PG8_BAR; PG8_WAIT_L(0); PG8_MMA(1, 0, At, B0); PG8_BAR; PG8_SCHED;
            PG8_STAGE(PG8_SB(1, 1), b3 + hstep, voffB);
            PG8_WAIT_V(6); PG8_BAR; PG8_MMA(1, 1, At, B1); PG8_BAR;
            }
        }
        if constexpr (ALIGN_EPI) { if (wr == 0) PG8_BAR; }
        if constexpr (!Epi::AFTER_DRAIN) { E(acc, cur, wr, wc, fr, fq); S.done(cur); }
        if (!has_next) break;
#pragma unroll
        for (int a = 0; a < 2; ++a)
#pragma unroll
            for (int b = 0; b < 2; ++b)
#pragma unroll
                for (int m = 0; m < 4; ++m)
#pragma unroll
                    for (int n = 0; n < 2; ++n) acc[a][b][m][n] = (f32x4){0.f, 0.f, 0.f, 0.f};
        cur = nxt; cA = nA; cB = nB; ++ui;
        if constexpr (ALIGN_EPI) { if (wr == 1) PG8_BAR; }
    }
    PG8_WAIT_V(0);
    if constexpr (!ALIGN_EPI) { if (wr == 0) PG8_BAR; }
    PG8_BAR;
    if constexpr (Epi::AFTER_DRAIN) { E.fused(acc, cur, wr, wc, fr, fq, lds, wid, lane); S.done(cur); }
#undef PG8_SA
#undef PG8_SB
#undef PG8_STAGE
#undef PG8_LDA
#undef PG8_LDB
#undef PG8_MMA
#undef PG8_WAIT_V
#undef PG8_WAIT_L
#undef PG8_BAR
#undef PG8_SCHED
}
}

#define GAS __attribute__((address_space(1)))
#define LAS __attribute__((address_space(3)))
typedef unsigned short bf16;
typedef unsigned v4u __attribute__((ext_vector_type(4)));
typedef unsigned v2u __attribute__((ext_vector_type(2)));
typedef float f32x4 __attribute__((ext_vector_type(4)));
typedef short bf16x8 __attribute__((ext_vector_type(8)));
typedef float f32x16 __attribute__((ext_vector_type(16)));
#define LDS_WAIT() asm volatile("s_waitcnt lgkmcnt(0)" ::: "memory")

constexpr int SEQ = 8192, DM = 2048, NIN = 10760, NWAVES = 8, NTHREADS = 512;
constexpr int LDP = pg8::LDP;
constexpr float LN_EPS = 1e-5f;
constexpr float LOG2E = 1.4426950408889634f;
constexpr float DN_ALPHA = 1.189207115002721f;
constexpr float NEG_BIG = -1e30f;

constexpr size_t MiB = 1u << 20;
constexpr size_t WS_ADA = 0;
constexpr size_t WS_BAR = 32 * 1024, WS_BAR_BYTES = 16 * 1024;
constexpr size_t WS_LOGF = 64 * 1024;
constexpr size_t WS_CUM = WS_LOGF + 256 * 1024;
constexpr size_t WS_WIN_T = 1 * MiB;
constexpr size_t WS_WBF_T = 44 * MiB;
constexpr size_t WS_WBS_T = 48 * MiB;
constexpr size_t WS_WOUT_T = 52 * MiB;
constexpr size_t WS_H = 64 * MiB;
constexpr size_t WS_PROJ = 96 * MiB;
constexpr size_t WS_AF = 264 * MiB;
constexpr size_t WS_AS = 280 * MiB;
constexpr size_t WS_END = 296 * MiB;

constexpr int LDS_BYTES = 147456, LDS_MISC_OFF = LDS_BYTES - 64;

__device__ __forceinline__ unsigned f2bf(float f) { unsigned u = __builtin_bit_cast(unsigned, f); return (u + 0x7fffu + ((u >> 16) & 1u)) >> 16; }
__device__ __forceinline__ unsigned pk2(float lo, float hi) { return f2bf(lo) | (f2bf(hi) << 16); }
__device__ __forceinline__ float bf2f(bf16 v) { return __builtin_bit_cast(float, (unsigned)v << 16); }
__device__ __forceinline__ float wave_sum(float v) {
#pragma unroll
    for (int o = 1; o < 64; o <<= 1) v += __shfl_xor(v, o);
    return v;
}
__device__ __forceinline__ float wave_max(float v) {
#pragma unroll
    for (int o = 1; o < 64; o <<= 1) v = fmaxf(v, __shfl_xor(v, o));
    return v;
}

struct Args { const float* in[12]; float* out; unsigned char* ws; int ph_lo, ph_hi; };

__device__ __forceinline__ void p0_transpose_item(const float* W, int K, int ldw, int N, bf16* WT, LAS float* scr, int item, int lane) {
    const int nblk = N / 32, kb = item / nblk, nb = item % nblk, k0 = 64 * kb, n0 = 32 * nb;
#pragma unroll 8
    for (int i = 0; i < 32; ++i) { const int kk = 2 * i + (lane >> 5); scr[kk * 33 + (lane & 31)] = W[(size_t)(k0 + kk) * ldw + n0 + (lane & 31)]; }
    LDS_WAIT(); asm volatile("" ::: "memory");
    const int c = lane & 7;
#pragma unroll
    for (int j = 0; j < 4; ++j) { const int n = (lane >> 3) + 8 * j; const LAS float* s = scr + (8 * c) * 33 + n;
        v4u o; o.x = pk2(s[0 * 33], s[1 * 33]); o.y = pk2(s[2 * 33], s[3 * 33]); o.z = pk2(s[4 * 33], s[5 * 33]); o.w = pk2(s[6 * 33], s[7 * 33]);
        *(v4u*)(WT + (size_t)(n0 + n) * K + k0 + 8 * c) = o; }
    LDS_WAIT(); asm volatile("" ::: "memory");
}

__device__ __forceinline__ void phase0(const Args& a, LAS unsigned char* lds) {
    const int tid = threadIdx.x, lane = tid & 63, wave = tid >> 6, G = gridDim.x;
    const float* c = a.in[1]; const float* w_ada = a.in[2]; const float* b_ada = a.in[3];
    float* ada = (float*)(a.ws + WS_ADA);
    LAS float* red = (LAS float*)lds;
    for (int cb = blockIdx.x; cb < 256; cb += G) {
        const int c4 = tid % 6, ks = tid / 6;
        f32x4 acc = {0.f, 0.f, 0.f, 0.f};
        if (ks < 85) {
            for (int k = ks; k < DM; k += 85) { const f32x4 w = *(const f32x4*)(w_ada + (size_t)k * 6144 + 24 * cb + 4 * c4); acc += w * c[k]; }
            *(LAS f32x4*)(red + ks * 24 + 4 * c4) = acc;
        }
        __syncthreads();
        if (tid < 24) { float s = 0.f; for (int i = 0; i < 85; ++i) s += red[i * 24 + tid]; ada[24 * cb + tid] = s + b_ada[24 * cb + tid]; }
        __syncthreads();
    }
    LAS float* scr = (LAS float*)(lds + wave * 16384);
    const int gw = blockIdx.x * NWAVES + wave, NGW = G * NWAVES;
    const float* w_in = a.in[4];
    constexpr int I_A = (DM / 64) * (3072 / 32), I_B = (DM / 64) * (7680 / 32), I_F = (1024 / 64) * (DM / 32), I_O = (DM / 64) * (DM / 32);
    constexpr int NITEMS = I_A + I_B + 2 * I_F + I_O;
    bf16* win_t = (bf16*)(a.ws + WS_WIN_T);
    for (int it = gw; it < NITEMS; it += NGW) {
        int r = it;
        if (r < I_A) { p0_transpose_item(w_in, DM, NIN, 3072, win_t, scr, r, lane); continue; } r -= I_A;
        if (r < I_B) { p0_transpose_item(w_in + 3080, DM, NIN, 7680, win_t + (size_t)3072 * DM, scr, r, lane); continue; } r -= I_B;
        if (r < I_F) { p0_transpose_item(a.in[7], 1024, DM, DM, (bf16*)(a.ws + WS_WBF_T), scr, r, lane); continue; } r -= I_F;
        if (r < I_F) { p0_transpose_item(a.in[8], 1024, DM, DM, (bf16*)(a.ws + WS_WBS_T), scr, r, lane); continue; } r -= I_F;
        p0_transpose_item(a.in[9], DM, DM, DM, (bf16*)(a.ws + WS_WOUT_T), scr, r, lane);
    }
}

__device__ __forceinline__ void phase1(const Args& a, LAS unsigned char* lds) {
    const int tid = threadIdx.x, lane = tid & 63, wave = tid >> 6, G = gridDim.x;
    const float* x = a.in[0]; const float* w_in = a.in[4]; const float* b_f = a.in[5];
    const float* ada = (const float*)(a.ws + WS_ADA);
    bf16* H = (bf16*)(a.ws + WS_H);
    float* logf_ = (float*)(a.ws + WS_LOGF);
    LAS f32x4* w8 = (LAS f32x4*)lds;
    for (int i = tid; i < 4096; i += NTHREADS) { const int k = i >> 1, half = i & 1; const int l = (k >> 2) & 63, e = k & 3, j = k >> 8;
        w8[((half * 4 + e) * 8 + j) * 64 + l] = *(const f32x4*)(w_in + (size_t)k * NIN + 3072 + 4 * half); }
    __syncthreads();
    const int gw = blockIdx.x * NWAVES + wave, NGW = G * NWAVES;
    for (int m = gw; m < SEQ; m += NGW) {
        const f32x4* xr = (const f32x4*)(x + (size_t)m * DM) + lane;
        f32x4 v[8]; float s = 0.f;
#pragma unroll
        for (int j = 0; j < 8; ++j) { v[j] = xr[64 * j]; s += (v[j].x + v[j].y) + (v[j].z + v[j].w); }
        const float mean = wave_sum(s) * (1.f / DM); float s2 = 0.f;
#pragma unroll
        for (int j = 0; j < 8; ++j) { v[j] = v[j] - mean; s2 += (v[j].x * v[j].x + v[j].y * v[j].y) + (v[j].z * v[j].z + v[j].w * v[j].w); }
        const float rstd = 1.f / sqrtf(wave_sum(s2) * (1.f / DM) + LN_EPS);
        f32x4 al = {0.f, 0.f, 0.f, 0.f}, ah = {0.f, 0.f, 0.f, 0.f};
        v2u* o8 = (v2u*)(H + (size_t)m * DM) + lane;
#pragma unroll
        for (int j = 0; j < 8; ++j) {
            asm volatile("" ::: "memory");
            const f32x4 sh = *((const f32x4*)ada + lane + 64 * j), sc = *((const f32x4*)(ada + DM) + lane + 64 * j);
            const f32x4 hv = v[j] * rstd * (sc + 1.0f) + sh;
            v2u o; o.x = pk2(hv.x, hv.y); o.y = pk2(hv.z, hv.w); o8[64 * j] = o;
#pragma unroll
            for (int e = 0; e < 4; ++e) { const f32x4 wl = w8[((0 + e) * 8 + j) * 64 + lane], wh = w8[((4 + e) * 8 + j) * 64 + lane]; al += wl * hv[e]; ah += wh * hv[e]; }
        }
        float r8[8] = {al.x, al.y, al.z, al.w, ah.x, ah.y, ah.z, ah.w};
#pragma unroll
        for (int hh = 0; hh < 8; ++hh) r8[hh] = wave_sum(r8[hh]);
        if (lane < 8) { float t = r8[0];
#pragma unroll
            for (int hh = 1; hh < 8; ++hh) t = (lane == hh) ? r8[hh] : t;
            const float xx = t + b_f[lane];
            logf_[lane * SEQ + m] = fminf(xx, 0.f) - log1pf(expf(-fabsf(xx))); }
    }
}

__device__ __forceinline__ void scan_head(const Args& a, LAS unsigned char* lds, int h) {
    const int tid = threadIdx.x;
    const float* src = (const float*)(a.ws + WS_LOGF) + (size_t)h * SEQ + 16 * tid;
    float* dst = (float*)(a.ws + WS_CUM) + (size_t)h * SEQ + 16 * tid;
    LAS float* tot = (LAS float*)lds;
    float v[16];
#pragma unroll
    for (int i = 0; i < 4; ++i) { const f32x4 t = *((const f32x4*)src + i); v[4 * i] = t.x; v[4 * i + 1] = t.y; v[4 * i + 2] = t.z; v[4 * i + 3] = t.w; }
#pragma unroll
    for (int i = 1; i < 16; ++i) v[i] += v[i - 1];
    tot[tid] = v[15];
    __syncthreads();
    float base = 0.f;
    for (int i = 0; i < tid; ++i) base += tot[i];
#pragma unroll
    for (int i = 0; i < 4; ++i) { f32x4 t = {v[4 * i] + base, v[4 * i + 1] + base, v[4 * i + 2] + base, v[4 * i + 3] + base}; *((f32x4*)dst + i) = t; }
    __syncthreads();
}

template <bool FOX>
__device__ __forceinline__ void naive_attn(const Args& a, LAS unsigned char* lds) {
    constexpr int D = FOX ? 128 : 64, NH = FOX ? 8 : 16;
    const int tid = threadIdx.x, lane = tid & 63, wave = tid >> 6, G = gridDim.x;
    const bf16* P = (const bf16*)(a.ws + WS_PROJ);
    const float* cum = (const float*)(a.ws + WS_CUM);
    const float* sinks = a.in[6];
    bf16* O = (bf16*)(a.ws + (FOX ? WS_AF : WS_AS));
    LAS float* qs = (LAS float*)(lds + wave * 1024);
    LAS float* ps = qs + 128;
    const int gw = blockIdx.x * NWAVES + wave, NGW = G * NWAVES;
    for (int row = gw; row < SEQ * NH; row += NGW) {
        const int t = row / NH, h = row % NH;
        const int cq = (FOX ? pg8::C_FQ : pg8::C_SQ) + h * D;
        const int ck = FOX ? (pg8::C_FK + h * D) : (pg8::C_SK + (h >> 2) * D);
        const int cv = FOX ? (pg8::C_FV + h * D) : (pg8::C_SV + (h >> 2) * D);
        const int cg = (FOX ? pg8::C_GF : pg8::C_GS) + h * D;
        if (FOX) { qs[2 * lane] = bf2f(P[(size_t)t * LDP + cq + 2 * lane]); qs[2 * lane + 1] = bf2f(P[(size_t)t * LDP + cq + 2 * lane + 1]); }
        else qs[lane] = bf2f(P[(size_t)t * LDP + cq + lane]);
        LDS_WAIT();
        const float Ft = FOX ? cum[h * SEQ + t] : 0.f;
        const float slope2 = FOX ? 0.f : exp2f(-8.0f * (float)(h + 1) / 16.0f) * LOG2E;
        const int lo = FOX ? 0 : (t - 127 > 0 ? t - 127 : 0);
        float mrun = NEG_BIG, l = 0.f, o0 = 0.f, o1 = 0.f;
        for (int s0 = lo; s0 <= t; s0 += 64) {
            const int s = s0 + lane; const bool valid = s <= t;
            float xv = NEG_BIG;
            if (valid) { const bf16* kr = P + (size_t)s * LDP + ck; float dot = 0.f;
                for (int d = 0; d < D; d += 8) { const v4u kk = *(const v4u*)(kr + d);
                    dot += qs[d] * pg8::bf_lo(kk.x) + qs[d + 1] * pg8::bf_hi(kk.x) + qs[d + 2] * pg8::bf_lo(kk.y) + qs[d + 3] * pg8::bf_hi(kk.y)
                         + qs[d + 4] * pg8::bf_lo(kk.z) + qs[d + 5] * pg8::bf_hi(kk.z) + qs[d + 6] * pg8::bf_lo(kk.w) + qs[d + 7] * pg8::bf_hi(kk.w); }
                xv = FOX ? dot + (Ft - cum[h * SEQ + s]) * LOG2E : dot - slope2 * (float)(t - s); }
            const float mx = wave_max(xv), mnew = fmaxf(mrun, mx), alpha = exp2f(mrun - mnew);
            const float p = valid ? exp2f(xv - mnew) : 0.f;
            l = l * alpha + wave_sum(p); o0 *= alpha; o1 *= alpha; mrun = mnew;
            ps[lane] = p; LDS_WAIT();
            const int nj = (t - s0 + 1) < 64 ? (t - s0 + 1) : 64;
            for (int j = 0; j < nj; ++j) { const float pj = ps[j]; const bf16* vr = P + (size_t)(s0 + j) * LDP + cv;
                if (FOX) { const unsigned vv = *(const unsigned*)(vr + 2 * lane); o0 += pj * pg8::bf_lo(vv); o1 += pj * pg8::bf_hi(vv); }
                else o0 += pj * bf2f(vr[lane]); }
            LDS_WAIT();
        }
        if (!FOX) l += exp2f(sinks[h] * LOG2E - mrun);
        const float inv = 1.f / l;
        if (FOX) { const unsigned gg = *(const unsigned*)(P + (size_t)t * LDP + cg + 2 * lane);
            *(unsigned*)(O + (size_t)t * 1024 + h * D + 2 * lane) = pk2(o0 * inv * pg8::bf_lo(gg), o1 * inv * pg8::bf_hi(gg)); }
        else O[(size_t)t * 1024 + h * D + lane] = (bf16)f2bf(o0 * inv * bf2f(P[(size_t)t * LDP + cg + lane]));
    }
}

__device__ __forceinline__ void phase_ln_out(const Args& a) {
    const int tid = threadIdx.x, lane = tid & 63, wave = tid >> 6, G = gridDim.x;
    const float* lng = a.in[10]; const float* lnb = a.in[11];
    const int gw = blockIdx.x * NWAVES + wave, NGW = G * NWAVES;
    for (int m = gw; m < SEQ; m += NGW) {
        f32x4* zr = (f32x4*)(a.out + (size_t)m * DM) + lane;
        f32x4 v[8]; float s = 0.f;
#pragma unroll
        for (int j = 0; j < 8; ++j) { v[j] = zr[64 * j]; s += (v[j].x + v[j].y) + (v[j].z + v[j].w); }
        const float mean = wave_sum(s) * (1.f / DM); float s2 = 0.f;
#pragma unroll
        for (int j = 0; j < 8; ++j) { v[j] = v[j] - mean; s2 += (v[j].x * v[j].x + v[j].y * v[j].y) + (v[j].z * v[j].z + v[j].w * v[j].w); }
        const float rstd = 1.f / sqrtf(wave_sum(s2) * (1.f / DM) + LN_EPS);
#pragma unroll
        for (int j = 0; j < 8; ++j) { const f32x4 g = *((const f32x4*)lng + lane + 64 * j), b = *((const f32x4*)lnb + lane + 64 * j); zr[64 * j] = v[j] * rstd * g + b; }
    }
}

#define XB_TMO      128
#define XB_XCNT(j)  (256  + 64 * (j))
#define XB_XSUB(j)  (1280 + 64 * (j))
#define XB_XGEN(j)  (2304 + 64 * (j))
#define XB_TOP      3328
#define XB_TOPGEN   3392
#define XCD_BAR_WORDS 3456
#define XB_SPIN_CAP (1u << 18)

__device__ __forceinline__ unsigned xb_ld(unsigned* p)              { return __hip_atomic_load(p, __ATOMIC_RELAXED, __HIP_MEMORY_SCOPE_AGENT); }
__device__ __forceinline__ unsigned xb_add(unsigned* p, unsigned v) { return __hip_atomic_fetch_add(p, v, __ATOMIC_RELAXED, __HIP_MEMORY_SCOPE_AGENT); }
__device__ __forceinline__ unsigned xb_xcc_id() { return (unsigned)__builtin_amdgcn_s_getreg((3 << 11) | 20) & 0xFu; }
#define XB_SPIN(cond, bar) do { unsigned _sp = 0; while (cond) { __builtin_amdgcn_s_sleep(1); \
    if ((++_sp & 255u) == 0u) { if (xb_ld(&(bar)[XB_TMO])) break; if (_sp > XB_SPIN_CAP) { atomicAdd(&(bar)[XB_TMO], 1u); break; } } } } while (0)

struct XcdBarrier {
    unsigned* bar; unsigned x;
    volatile LAS unsigned* st;
};

__device__ __forceinline__ XcdBarrier xcd_barrier_post(unsigned* bar, volatile LAS unsigned* st) {
    XcdBarrier b; b.bar = bar; b.x = xb_xcc_id(); b.st = st;
    if (threadIdx.x == 0) (void)xb_add(&bar[XB_XCNT(b.x)], 1u);
    return b;
}
__device__ __forceinline__ void xcd_barrier_complete(unsigned* bar, unsigned x, unsigned& nloc, unsigned& nx) {
    const unsigned G = gridDim.x * gridDim.y * gridDim.z;
    unsigned sum, cnt, mine, sp = 0u;
    for (;;) {
        sum = 0u; cnt = 0u; mine = 0u;
#pragma unroll
        for (unsigned j = 0; j < 16; ++j) { const unsigned c = xb_ld(&bar[XB_XCNT(j)]); sum += c; cnt += (c > 0u) ? 1u : 0u; mine = (j == x) ? c : mine; }
        if (sum == G) break;
        __builtin_amdgcn_s_sleep(1);
        if ((++sp & 255u) == 0u) { if (xb_ld(&bar[XB_TMO])) break; if (sp > XB_SPIN_CAP) { atomicAdd(&bar[XB_TMO], 1u); break; } }
    }
    nloc = mine > 0u ? mine : 1u; nx = cnt > 0u ? cnt : 1u;
}

__device__ __forceinline__ void xcd_barrier(const XcdBarrier& b) {
    asm volatile("s_waitcnt vmcnt(0)" ::: "memory");
    __syncthreads();
    if (threadIdx.x == 0) {
        unsigned* bar = b.bar;
        __builtin_amdgcn_s_waitcnt(0);
        unsigned nloc = b.st[0], nx = b.st[1];
        if (nloc == 0u) { xcd_barrier_complete(bar, b.x, nloc, nx); b.st[0] = nloc; b.st[1] = nx; }
        const unsigned old = xb_add(&bar[XB_XSUB(b.x)], 1u);
        const unsigned gen = old / nloc;
        if (old + 1u == (gen + 1u) * nloc) {
            __builtin_amdgcn_fence(__ATOMIC_RELEASE, "agent");
            asm volatile("s_waitcnt vmcnt(0)" ::: "memory");
            const unsigned og = xb_add(&bar[XB_TOP], 1u);
            const unsigned tg = og / nx;
            if (og + 1u == (tg + 1u) * nx) xb_add(&bar[XB_TOPGEN], 1u);
            else XB_SPIN(xb_ld(&bar[XB_TOPGEN]) == tg, bar);
            __builtin_amdgcn_fence(__ATOMIC_ACQUIRE, "agent");
            xb_add(&bar[XB_XGEN(b.x)], 1u);
            asm volatile("s_waitcnt vmcnt(0)" ::: "memory");
        } else {
            XB_SPIN(xb_ld(&bar[XB_XGEN(b.x)]) == gen, bar);
            __builtin_amdgcn_fence(__ATOMIC_ACQUIRE, "agent");
            asm volatile("s_waitcnt vmcnt(0)" ::: "memory");
        }
    }
    __syncthreads();
}


typedef short s16x4 __attribute__((ext_vector_type(4)));
typedef short v4i16_t __attribute__((ext_vector_type(4)));
typedef float f32x2_t __attribute__((ext_vector_type(2)));
typedef __bf16 bf16x2_t __attribute__((ext_vector_type(2)));
#define MFMA32(a, b, c) __builtin_amdgcn_mfma_f32_32x32x16_bf16((a), (b), (c), 0, 0, 0)
__device__ __forceinline__ s16x4 vtr(LAS const unsigned char* p) { return __builtin_bit_cast(s16x4, __builtin_amdgcn_ds_read_tr16_b64_v4i16((LAS v4i16_t*)p)); }
__device__ __forceinline__ unsigned cvtpk(float lo, float hi) { f32x2_t v = {lo, hi}; bf16x2_t b = __builtin_convertvector(v, bf16x2_t); return __builtin_bit_cast(unsigned, b); }
__device__ __forceinline__ float xor32_max(float v) { auto rr = __builtin_amdgcn_permlane32_swap(__float_as_uint(v), __float_as_uint(v), false, false); return fmaxf(__uint_as_float(rr[0]), __uint_as_float(rr[1])); }
__device__ __forceinline__ float xor32_sum(float v) { auto rr = __builtin_amdgcn_permlane32_swap(__float_as_uint(v), __float_as_uint(v), false, false); return __uint_as_float(rr[0]) + __uint_as_float(rr[1]); }
__device__ __forceinline__ int crow(int i, int h) { return (i & 3) + 8 * (i >> 2) + 4 * h; }

template <bool FOX> struct AC {
    static constexpr int D = FOX ? 128 : 64, NDS = D / 16, NDB = D / 32;
    static constexpr int KSTR = D * 2 + 16, VSTR = FOX ? 320 : 192;
    static constexpr int OFF_K = 0, OFF_V = 128 * KSTR, OFF_B = OFF_V + 128 * VSTR, END = OFF_B + 512;
    static constexpr int CPR = D / 8, NCH = 128 * CPR / NTHREADS;
    static constexpr int W = FOX ? (1 << 30) : 128;
};

template <bool FOX>
__device__ __forceinline__ bool attn_tileA(LAS const unsigned char* Kb, LAS const float* Bb,
                                           const bf16x8 (&qf)[AC<FOX>::NDS], f32x16 (&oT)[AC<FOX>::NDB], float& m, float& l, bf16x8 (&pf)[2][2],
                                           int ka, int ta, int lane, float slope2) {
    typedef AC<FOX> C;
    const int dmax = ta + 31 - ka, dmin = ta - ka - 63;
    if (dmax < 0 || dmin >= C::W) return false;
    const bool need_mask = (dmin < 0) || (dmax >= C::W);
    const int r = lane & 31, h = lane >> 5;
    f32x16 s0, s1;
    if (FOX) {
#pragma unroll
        for (int g4 = 0; g4 < 4; ++g4) { const f32x4 b0 = *(LAS const f32x4*)(Bb + 8 * g4 + 4 * h), b1 = *(LAS const f32x4*)(Bb + 32 + 8 * g4 + 4 * h);
#pragma unroll
            for (int e = 0; e < 4; ++e) { s0[4 * g4 + e] = b0[e]; s1[4 * g4 + e] = b1[e]; } }
    } else {
#pragma unroll
        for (int i = 0; i < 16; ++i) { s0[i] = 0.f; s1[i] = 0.f; }
    }
    LAS const unsigned char* kp = Kb + r * C::KSTR + h * 16;
#pragma unroll
    for (int ds = 0; ds < C::NDS; ++ds) {
        const bf16x8 k0 = *(LAS const bf16x8*)(kp + ds * 32), k1 = *(LAS const bf16x8*)(kp + 32 * C::KSTR + ds * 32);
        s0 = MFMA32(k0, qf[ds], s0); s1 = MFMA32(k1, qf[ds], s1);
    }
    const int tl = ta + r - ka;
    if (!FOX) {
#pragma unroll
        for (int i = 0; i < 16; ++i) { const float d0 = (float)(tl - crow(i, h)); s0[i] -= slope2 * d0; s1[i] -= slope2 * (d0 - 32.f); }
    }
    if (need_mask) {
#pragma unroll
        for (int i = 0; i < 16; ++i) { const int d0 = tl - crow(i, h), d1 = d0 - 32;
            if (d0 < 0 || d0 >= C::W) s0[i] = -1e30f;
            if (d1 < 0 || d1 >= C::W) s1[i] = -1e30f; }
    }
    float mx = fmaxf(s0[0], s1[0]);
#pragma unroll
    for (int i = 1; i < 16; ++i) mx = fmaxf(mx, fmaxf(s0[i], s1[i]));
    mx = xor32_max(mx);
    const float mnew = fmaxf(m, mx), alpha = __builtin_amdgcn_exp2f(m - mnew);
    m = mnew;
    float ps = 0.f;
#pragma unroll
    for (int i = 0; i < 16; ++i) { s0[i] = __builtin_amdgcn_exp2f(s0[i] - mnew); s1[i] = __builtin_amdgcn_exp2f(s1[i] - mnew); ps += s0[i] + s1[i]; }
    l = l * alpha + ps;
#pragma unroll
    for (int db = 0; db < C::NDB; ++db) oT[db] = oT[db] * alpha;
#pragma unroll
    for (int s = 0; s < 2; ++s) {
        v4u a, b;
        a.x = cvtpk(s0[8 * s], s0[8 * s + 1]); a.y = cvtpk(s0[8 * s + 2], s0[8 * s + 3]); a.z = cvtpk(s0[8 * s + 4], s0[8 * s + 5]); a.w = cvtpk(s0[8 * s + 6], s0[8 * s + 7]);
        b.x = cvtpk(s1[8 * s], s1[8 * s + 1]); b.y = cvtpk(s1[8 * s + 2], s1[8 * s + 3]); b.z = cvtpk(s1[8 * s + 4], s1[8 * s + 5]); b.w = cvtpk(s1[8 * s + 6], s1[8 * s + 7]);
        pf[0][s] = __builtin_bit_cast(bf16x8, a); pf[1][s] = __builtin_bit_cast(bf16x8, b);
    }
    return true;
}
template <bool FOX>
__device__ __forceinline__ void attn_tileB(LAS const unsigned char* Vb, f32x16 (&oT)[AC<FOX>::NDB], const bf16x8 (&pf)[2][2], int lane) {
    typedef AC<FOX> C;
    const int h = lane >> 5;
    const int i16 = lane & 15, qq = i16 >> 2, pp = i16 & 3, blk = (lane >> 4) & 1;
    LAS const unsigned char* vp = Vb + (4 * h + qq) * C::VSTR + (16 * blk + 4 * pp) * 2;
#pragma unroll
    for (int db = 0; db < C::NDB; ++db)
#pragma unroll
        for (int b = 0; b < 2; ++b)
#pragma unroll
            for (int s = 0; s < 2; ++s) {
                const s16x4 lo = vtr(vp + (32 * b + 16 * s) * C::VSTR + 64 * db), hi = vtr(vp + (32 * b + 16 * s + 8) * C::VSTR + 64 * db);
                const bf16x8 va = __builtin_shufflevector(lo, hi, 0, 1, 2, 3, 4, 5, 6, 7);
                oT[db] = MFMA32(va, pf[b][s], oT[db]);
            }
}

template <bool FOX>
__device__ __forceinline__ void stage_load(v4u (&kr)[AC<FOX>::NCH], v4u (&vr)[AC<FOX>::NCH], const bf16* Pk, const bf16* Pv, int key0, int tid) {
    typedef AC<FOX> C;
#pragma unroll
    for (int i = 0; i < C::NCH; ++i) { const int c = tid + NTHREADS * i, row = c / C::CPR, ch = c % C::CPR; const size_t off = (size_t)(key0 + row) * LDP + ch * 8;
        kr[i] = *(const v4u*)(Pk + off); vr[i] = *(const v4u*)(Pv + off); }
}
template <bool FOX>
__device__ __forceinline__ void stage_store(const v4u (&kr)[AC<FOX>::NCH], const v4u (&vr)[AC<FOX>::NCH], LAS unsigned char* lds, int tid) {
    typedef AC<FOX> C;
#pragma unroll
    for (int i = 0; i < C::NCH; ++i) { const int c = tid + NTHREADS * i, row = c / C::CPR, ch = c % C::CPR;
        *(LAS v4u*)(lds + C::OFF_K + row * C::KSTR + ch * 16) = kr[i]; *(LAS v4u*)(lds + C::OFF_V + row * C::VSTR + ch * 16) = vr[i]; }
}

__device__ __forceinline__ void fox_unit(const Args& a, LAS unsigned char* lds, int hd, int qb) {
    typedef AC<true> C;
    const int tid = threadIdx.x, lane = tid & 63, wave = __builtin_amdgcn_readfirstlane(tid >> 6), rg = wave & 3, g = wave >> 2;
    const int r = lane & 31, hh = lane >> 5;
    const bf16* P = (const bf16*)(a.ws + WS_PROJ);
    const bf16* Pq = P + pg8::C_FQ + hd * 128; const bf16* Pk = P + pg8::C_FK + hd * 128; const bf16* Pv = P + pg8::C_FV + hd * 128; const bf16* Pg = P + pg8::C_GF + hd * 128;
    const float* cumh = (const float*)(a.ws + WS_CUM) + (size_t)hd * SEQ;
    bf16* O = (bf16*)(a.ws + WS_AF);
    const int q0 = 128 * qb, tq = q0 + 32 * rg + r;
    bf16x8 qf[C::NDS];
#pragma unroll
    for (int ds = 0; ds < C::NDS; ++ds) qf[ds] = *(const bf16x8*)(Pq + (size_t)tq * LDP + ds * 16 + hh * 8);
    const float Fq0 = cumh[q0];
    f32x16 oT[C::NDB];
#pragma unroll
    for (int db = 0; db < C::NDB; ++db)
#pragma unroll
        for (int i = 0; i < 16; ++i) oT[db][i] = 0.f;
    float m = -1e20f, l = 0.f;
    v4u kr[C::NCH], vr[C::NCH]; float breg = 0.f;
    stage_load<true>(kr, vr, Pk, Pv, 0, tid); if (tid < 128) breg = cumh[tid];
    LAS float* ldsB = (LAS float*)(lds + C::OFF_B);
    for (int s = 0; s <= qb; ++s) {
        __syncthreads();
        stage_store<true>(kr, vr, lds, tid); if (tid < 128) ldsB[tid] = (Fq0 - breg) * LOG2E;
        __syncthreads();
        bf16x8 pf[2][2];
        const bool act = attn_tileA<true>(lds + C::OFF_K + 64 * g * C::KSTR, ldsB + 64 * g, qf, oT, m, l, pf, 128 * s + 64 * g, q0 + 32 * rg, lane, 0.f);
        if (s < qb) { stage_load<true>(kr, vr, Pk, Pv, 128 * (s + 1), tid); if (tid < 128) breg = cumh[128 * (s + 1) + tid]; }
        if (act) attn_tileB<true>(lds + C::OFF_V + 64 * g * C::VSTR, oT, pf, lane);
    }
    __syncthreads();
    LAS float* mg = (LAS float*)lds + rg * (66 * 64) + lane;
    if (g == 1) {
#pragma unroll
        for (int db = 0; db < C::NDB; ++db)
#pragma unroll
            for (int i = 0; i < 16; ++i) mg[(db * 16 + i) * 64] = oT[db][i];
        mg[64 * 64] = m; mg[65 * 64] = l;
    }
    __syncthreads();
    if (g == 0) {
        const float m1 = mg[64 * 64], l1 = mg[65 * 64], mt = fmaxf(m, m1), a0 = __builtin_amdgcn_exp2f(m - mt), a1 = __builtin_amdgcn_exp2f(m1 - mt);
        const float inv = 1.0f / xor32_sum(a0 * l + a1 * l1);
        const float s0 = a0 * inv, s1 = a1 * inv;
#pragma unroll
        for (int db = 0; db < C::NDB; ++db)
#pragma unroll
            for (int g4 = 0; g4 < 4; ++g4) { const int d = 32 * db + 8 * g4 + 4 * hh;
                asm volatile("" ::: "memory");
                const v2u gg = *(const v2u*)(Pg + (size_t)tq * LDP + d);
                const float o0 = (s0 * oT[db][4 * g4] + s1 * mg[(db * 16 + 4 * g4) * 64]) * pg8::bf_lo(gg.x), o1 = (s0 * oT[db][4 * g4 + 1] + s1 * mg[(db * 16 + 4 * g4 + 1) * 64]) * pg8::bf_hi(gg.x);
                const float o2 = (s0 * oT[db][4 * g4 + 2] + s1 * mg[(db * 16 + 4 * g4 + 2) * 64]) * pg8::bf_lo(gg.y), o3 = (s0 * oT[db][4 * g4 + 3] + s1 * mg[(db * 16 + 4 * g4 + 3) * 64]) * pg8::bf_hi(gg.y);
                v2u w; w.x = cvtpk(o0, o1); w.y = cvtpk(o2, o3);
                *(v2u*)(O + (size_t)tq * 1024 + hd * 128 + d) = w; }
    }
}

__device__ __forceinline__ void swa_unit(const Args& a, LAS unsigned char* lds, int nb, int hp) {
    typedef AC<false> C;
    const int tid = threadIdx.x, lane = tid & 63, wave = __builtin_amdgcn_readfirstlane(tid >> 6), rg = wave & 3, g = wave >> 2;
    const int r = lane & 31, hh = lane >> 5;
    const int head = 2 * hp + g, kvh = hp >> 1;
    const bf16* P = (const bf16*)(a.ws + WS_PROJ);
    const bf16* Pq = P + pg8::C_SQ + head * 64; const bf16* Pk = P + pg8::C_SK + kvh * 64; const bf16* Pv = P + pg8::C_SV + kvh * 64; const bf16* Pg = P + pg8::C_GS + head * 64;
    bf16* O = (bf16*)(a.ws + WS_AS);
    const int q0 = 128 * nb, tq = q0 + 32 * rg + r;
    const float slope2 = exp2f(-8.0f * (float)(head + 1) / 16.0f) * LOG2E;
    bf16x8 qf[C::NDS];
#pragma unroll
    for (int ds = 0; ds < C::NDS; ++ds) qf[ds] = *(const bf16x8*)(Pq + (size_t)tq * LDP + ds * 16 + hh * 8);
    f32x16 oT[C::NDB];
#pragma unroll
    for (int db = 0; db < C::NDB; ++db)
#pragma unroll
        for (int i = 0; i < 16; ++i) oT[db][i] = 0.f;
    float m = -1e20f, l = 0.f;
    v4u kr[C::NCH], vr[C::NCH];
    const int sfirst = nb > 0 ? nb - 1 : 0;
    stage_load<false>(kr, vr, Pk, Pv, 128 * sfirst, tid);
    for (int s = sfirst; s <= nb; ++s) {
        __syncthreads();
        stage_store<false>(kr, vr, lds, tid);
        __syncthreads();
        if (s < nb) stage_load<false>(kr, vr, Pk, Pv, 128 * (s + 1), tid);
#pragma unroll 1
        for (int jt = 0; jt < 2; ++jt)
        { bf16x8 pf[2][2];
            if (attn_tileA<false>(lds + C::OFF_K + 64 * jt * C::KSTR, nullptr, qf, oT, m, l, pf, 128 * s + 64 * jt, q0 + 32 * rg, lane, slope2))
                attn_tileB<false>(lds + C::OFF_V + 64 * jt * C::VSTR, oT, pf, lane); }
    }
    const float inv = 1.0f / (xor32_sum(l) + __builtin_amdgcn_exp2f(a.in[6][head] * LOG2E - m));
#pragma unroll
    for (int db = 0; db < C::NDB; ++db)
#pragma unroll
        for (int g4 = 0; g4 < 4; ++g4) { const int d = 32 * db + 8 * g4 + 4 * hh;
            const v2u gg = *(const v2u*)(Pg + (size_t)tq * LDP + d);
            const float o0 = oT[db][4 * g4] * inv * pg8::bf_lo(gg.x), o1 = oT[db][4 * g4 + 1] * inv * pg8::bf_hi(gg.x), o2 = oT[db][4 * g4 + 2] * inv * pg8::bf_lo(gg.y), o3 = oT[db][4 * g4 + 3] * inv * pg8::bf_hi(gg.y);
            v2u w; w.x = cvtpk(o0, o1); w.y = cvtpk(o2, o3);
            *(v2u*)(O + (size_t)tq * 1024 + head * 64 + d) = w; }
}

#ifndef ATTN_FOX_FAST
#define ATTN_FOX_FAST 1
#endif
#ifndef ATTN_SWA_FAST
#define ATTN_SWA_FAST 1
#endif
__device__ __forceinline__ void phase_attn(const Args& a, LAS unsigned char* lds) {
    const int G = gridDim.x;
#if ATTN_FOX_FAST
    for (int p = blockIdx.x; p < 256; p += G) { const int hd = p & 7, j = p >> 3;
#pragma unroll 1
        for (int k = 0; k < 2; ++k) fox_unit(a, lds, hd, k ? j : 63 - j); }
#else
    naive_attn<true>(a, lds);
#endif
    __syncthreads();
#if ATTN_SWA_FAST
    for (int u = blockIdx.x; u < 512; u += G) { const int hp = u & 7, nb = u >> 3; swa_unit(a, lds, nb, hp); }
#else
    naive_attn<false>(a, lds);
#endif
}

constexpr int N_PHASES = 7;
__global__ void __launch_bounds__(NTHREADS) fwd_megakernel(Args args) {
    extern __shared__ __attribute__((aligned(16))) unsigned char lds_raw[];
    LAS unsigned char* lds = (LAS unsigned char*)lds_raw;
    cg::grid_group grid = cg::this_grid();
    const int lo = args.ph_lo, hi = args.ph_hi;
    const bool one = (lo == 0 && hi == N_PHASES);
    unsigned char* ws = args.ws;
    volatile LAS unsigned* misc = (volatile LAS unsigned*)(lds + LDS_MISC_OFF);
    if (threadIdx.x < 16) misc[threadIdx.x] = 0u;
    __syncthreads();
    XcdBarrier bar; bar.bar = (unsigned*)(ws + WS_BAR); bar.x = 0; bar.st = misc;
    if (one) bar = xcd_barrier_post((unsigned*)(ws + WS_BAR), misc);
#define IN(k) (lo <= (k) && (k) < hi)
#define SEAM_CG() do { if (one) grid.sync(); } while (0)
#define SEAM() do { if (one) xcd_barrier(bar); } while (0)
    if (IN(0)) { phase0(args, lds); SEAM_CG(); }
    if (IN(1)) { phase1(args, lds); SEAM(); }
    if (IN(2)) {
        if (blockIdx.x < 8) scan_head(args, lds, blockIdx.x);
        pg8::Gemm g{(const pg8::bf16_t*)(ws + WS_H), (const pg8::bf16_t*)(ws + WS_WIN_T), SEQ, LDP, DM};
        pg8::StaticOrder S; S.init(SEQ, LDP, gridDim.x, (int)blockIdx.x);
        pg8::EpiProj E{(pg8::bf16_t*)(ws + WS_PROJ)};
        pg8::gemm_phase<pg8::EpiProj, pg8::StaticOrder, true, true>(lds, g, S, E);
        SEAM();
    }
    if (IN(3)) { phase_attn(args, lds); SEAM(); }
    if (IN(4)) {
        pg8::StaticOrder S; S.init(SEQ, DM, gridDim.x, (int)blockIdx.x);
        { pg8::Gemm g{(const pg8::bf16_t*)(ws + WS_AF), (const pg8::bf16_t*)(ws + WS_WBF_T), SEQ, DM, 1024};
          pg8::EpiPartial E{args.out, (const pg8::bf16_t*)(ws + WS_PROJ) + pg8::C_MF};
          pg8::gemm_phase<pg8::EpiPartial, pg8::StaticOrder, true, true>(lds, g, S, E); }
        __syncthreads();
        { pg8::Gemm g{(const pg8::bf16_t*)(ws + WS_AS), (const pg8::bf16_t*)(ws + WS_WBS_T), SEQ, DM, 1024};
          pg8::EpiMerge E{args.out, (const pg8::bf16_t*)(ws + WS_PROJ) + pg8::C_MS, (pg8::bf16_t*)(ws + WS_H)};
          pg8::gemm_phase<pg8::EpiMerge, pg8::StaticOrder, true, true>(lds, g, S, E); }
        SEAM();
    }
    if (IN(5)) {
        pg8::StaticOrder S; S.init(SEQ, DM, gridDim.x, (int)blockIdx.x);
        pg8::Gemm g{(const pg8::bf16_t*)(ws + WS_H), (const pg8::bf16_t*)(ws + WS_WOUT_T), SEQ, DM, DM};
        pg8::EpiZ E{args.in[0], (const float*)(ws + WS_ADA) + 2 * DM, args.out, DN_ALPHA};
        pg8::gemm_phase<pg8::EpiZ, pg8::StaticOrder, true, true>(lds, g, S, E);
        SEAM();
    }
    if (IN(6)) { phase_ln_out(args); }
#undef IN
#undef SEAM
#undef SEAM_CG
}

#ifndef MK_N_LAUNCHES
#define MK_N_LAUNCHES 1
#endif
extern "C" void kernel_launch(void* const* d_in, const int* in_sizes, int n_in, void* d_out, int out_size, void* d_ws, size_t ws_size, hipStream_t stream) {
    static int grid = 0;
    if (grid == 0) {
        if (n_in != 12 || out_size != SEQ * DM || ws_size < WS_END) { fprintf(stderr, "kernel_launch: unexpected shapes (n_in %d out %d ws %zu)\n", n_in, out_size, ws_size); grid = -1; return; }
        int dev = 0, cus = 0, per_cu = 0;
        hipGetDevice(&dev);
        hipDeviceGetAttribute(&cus, hipDeviceAttributeMultiprocessorCount, dev);
        if (hipFuncSetAttribute((const void*)fwd_megakernel, hipFuncAttributeMaxDynamicSharedMemorySize, LDS_BYTES) != hipSuccess) { fprintf(stderr, "kernel_launch: hipFuncSetAttribute failed\n"); grid = -1; return; }
        if (hipOccupancyMaxActiveBlocksPerMultiprocessor(&per_cu, (const void*)fwd_megakernel, NTHREADS, LDS_BYTES) != hipSuccess || per_cu < 1) { fprintf(stderr, "kernel_launch: occupancy query says %d\n", per_cu); per_cu = 1; }
        (void)hipGetLastError();
        grid = cus * (per_cu > 1 ? 1 : per_cu);
        fprintf(stderr, "kernel_launch: grid %d (cus %d per_cu %d)\n", grid, cus, per_cu);
    }
    if (grid < 0) return;
    Args a{};
    for (int i = 0; i < 12; ++i) a.in[i] = (const float*)d_in[i];
    a.out = (float*)d_out; a.ws = (unsigned char*)d_ws;
#if MK_N_LAUNCHES == 1
    if (hipMemsetAsync((char*)d_ws + WS_BAR, 0, WS_BAR_BYTES, stream) != hipSuccess) { fprintf(stderr, "kernel_launch: memset failed\n"); return; }
    a.ph_lo = 0; a.ph_hi = N_PHASES;
    void* kargs[] = {&a};
    hipError_t e = hipLaunchCooperativeKernel((const void*)fwd_megakernel, dim3(grid), dim3(NTHREADS), kargs, LDS_BYTES, stream);
    if (e != hipSuccess) fprintf(stderr, "cooperative launch failed: %s (grid %d)\n", hipGetErrorString(e), grid);
#else
#ifndef PROBE_REP
#define PROBE_REP -1
#endif
    for (int p = 0; p < N_PHASES; ++p) { a.ph_lo = p; a.ph_hi = p + 1;
        for (int rep = 0; rep < (p == PROBE_REP ? 2 : 1); ++rep) hipLaunchKernelGGL(fwd_megakernel, dim3(grid), dim3(NTHREADS), LDS_BYTES, stream, a); }
#endif
}
```

```cpp
#include <hip/hip_runtime.h>
#include <hip/hip_cooperative_groups.h>
#include <cstdio>
#include <cstdint>
#include <cmath>
namespace cg = cooperative_groups;
namespace pg8 {
#define PG8_LAS __attribute__((address_space(3)))
typedef unsigned short bf16_t;
typedef short bf16x8 __attribute__((ext_vector_type(8)));
typedef float f32x4 __attribute__((ext_vector_type(4)));
typedef unsigned u32x4 __attribute__((ext_vector_type(4)));
constexpr int BM = 256, BK = 64, HALF = 128, HTB = HALF * BK * 2  , STAGE_BYTES = 8 * HTB, NXCD = 8, WGM = 8;

__host__ __device__ __forceinline__ int lds_byte(int r, int c) { const int st = (r >> 4) * 2 + (c >> 5), rr = r & 15, cc = c & 31, ob = rr * 64 + cc * 2; return st * 1024 + (ob ^ (((ob >> 9) & 1) << 5)); }
__host__ __device__ __forceinline__ void stage_rc(int b, int& R, int& C) { const int st = b / 1024, sb = b % 1024, swz = sb ^ (((sb >> 9) & 1) << 5); R = (st >> 1) * 16 + swz / 64; C = (st & 1) * 32 + (swz % 64) / 2; }
__host__ __device__ __forceinline__ int perm32(int rho) { const int n = rho >> 4, i = rho & 15; return 8 * (i >> 2) + 4 * n + (i & 3); }

struct Unit { int pm, pn; };
struct Gemm { const bf16_t* A; const bf16_t* Bt; int M, N, K; };

struct StaticOrder {
    int nM, nN, nwg, G, c;
    __host__ __device__ void init(int M, int N, int G_, int c_) { nM = M / BM; nN = N / BM; nwg = nM * nN; G = G_; c = c_; }
    __host__ __device__ bool next(int i, Unit& u) const {
        const long L = (long)i * G + c; if (L >= nwg) return false;
        int wgid = (int)L; { const int q = nwg / NXCD, r = nwg % NXCD, xcd = wgid % NXCD, off = wgid / NXCD; wgid = (xcd < r ? xcd * (q + 1) : r * (q + 1) + (xcd - r) * q) + off; }
        const int nig = WGM * nN, gid = wgid / nig, fm = gid * WGM, gsz = (nM - fm) < WGM ? (nM - fm) : WGM;
        u.pm = fm + ((wgid % nig) % gsz); u.pn = (wgid % nig) / gsz; return true;
    }
    __device__ __forceinline__ void a_ready(const Unit&) const {}
    __device__ __forceinline__ void done(const Unit&) const {}
};

__device__ __forceinline__ unsigned cvt_pk_bf16(float lo, float hi) { unsigned r; asm volatile("v_cvt_pk_bf16_f32 %0, %1, %2" : "=v"(r) : "v"(lo), "v"(hi)); return r; }
typedef float f32x2 __attribute__((ext_vector_type(2)));

typedef unsigned u32x4e __attribute__((ext_vector_type(4)));
__device__ __forceinline__ float bf_lo(unsigned w) { return __builtin_bit_cast(float, w << 16); }
__device__ __forceinline__ float bf_hi(unsigned w) { return __builtin_bit_cast(float, w & 0xffff0000u); }
__device__ __forceinline__ float sigmoidf_fast(float x) { return __builtin_amdgcn_rcpf(1.0f + __builtin_amdgcn_exp2f(-1.4426950408889634f * x)); }
constexpr int LDP = 10752;
constexpr int SEQ_ = 8192;
constexpr size_t R_FQ = 0, R_FK = (size_t)SEQ_ * 1024, R_FV = (size_t)2 * SEQ_ * 1024, R_SQ = (size_t)3 * SEQ_ * 1024, R_SK = (size_t)4 * SEQ_ * 1024, R_SV = R_SK + (size_t)SEQ_ * 256,
                 R_GF = R_SV + (size_t)SEQ_ * 256, R_GS = R_GF + (size_t)SEQ_ * 1024, R_MF = R_GS + (size_t)SEQ_ * 1024, R_MS = R_MF + (size_t)SEQ_ * 2048;
constexpr int C_FQ = 0, C_FK = 1024, C_FV = 2048, C_SQ = 3072, C_SK = 4096, C_SV = 4352, C_GF = 4608, C_GS = 5632, C_MF = 6656, C_MS = 8704;
constexpr float QS_FOX = 0.08838834764831845f * 1.4426950408889634f;
constexpr float QS_SWA = 0.125f * 1.4426950408889634f;

struct EpiProj {
    static constexpr bool PERM = true, AFTER_DRAIN = false;
    bf16_t* O;
    __device__ __forceinline__ void operator()(const f32x4 (&acc)[2][2][4][2], const Unit& u, int wr, int wc, int fr, int fq) const {
        const int pn = u.pn;
        int mode = 0; float sc = 1.f;
        size_t boff; int c0, rs, hsh;
        if (pn < 12) { const int t = pn >> 2; boff = (size_t)t * SEQ_ * 1024; c0 = t * 1024; rs = 128; hsh = 7; if (t == 0) sc = QS_FOX; }
        else if (pn < 16) { boff = (size_t)3 * SEQ_ * 1024; c0 = 3072; rs = 64; hsh = 6; sc = QS_SWA; }
        else if (pn < 18) { boff = (size_t)4 * SEQ_ * 1024 + (size_t)(pn - 16) * SEQ_ * 256; c0 = 4096 + (pn - 16) * 256; rs = 64; hsh = 6; }
        else if (pn < 26) { const int t = (pn - 18) >> 2; boff = (size_t)4 * SEQ_ * 1024 + (size_t)SEQ_ * 512 + (size_t)t * SEQ_ * 1024; c0 = 4608 + t * 1024; rs = 1024; hsh = 31; mode = 1; }
        else { const int t = (pn - 26) >> 3; boff = (size_t)6 * SEQ_ * 1024 + (size_t)SEQ_ * 512 + (size_t)t * SEQ_ * 2048; c0 = 6656 + t * 2048; rs = 2048; hsh = 31; mode = 2; }
        const int row0 = u.pm * BM + wr * 64 + fr; const int crel0 = pn * BM + wc * 32 + 8 * fq - c0;
#pragma unroll
        for (int bj = 0; bj < 2; ++bj) { const int crel = crel0 + bj * HALF;
            const int head = (hsh == 31) ? 0 : (crel >> hsh), d = (hsh == 31) ? crel : (crel & ((1 << hsh) - 1));
            bf16_t* colp = O + boff + (size_t)head * SEQ_ * rs + d;
#pragma unroll
            for (int ai = 0; ai < 2; ++ai)
#pragma unroll
                for (int m = 0; m < 4; ++m) { f32x4 v0 = acc[ai][bj][m][0], v1 = acc[ai][bj][m][1];
                    if (mode == 0) { v0 = v0 * sc; v1 = v1 * sc; }
                    else {
#pragma unroll
                        for (int e = 0; e < 4; ++e) { const float s0 = sigmoidf_fast(v0[e]), s1 = sigmoidf_fast(v1[e]); v0[e] = (mode == 1) ? v0[e] * s0 : s0; v1[e] = (mode == 1) ? v1[e] * s1 : s1; }
                    }
                    u32x4e w; w.x = cvt_pk_bf16(v0[0], v0[1]); w.y = cvt_pk_bf16(v0[2], v0[3]); w.z = cvt_pk_bf16(v1[0], v1[1]); w.w = cvt_pk_bf16(v1[2], v1[3]);
                    *(u32x4e*)(colp + (size_t)(row0 + ai * HALF + m * 16) * rs) = w; } }
    }
};
struct EpiPartial {
    static constexpr bool PERM = true, AFTER_DRAIN = false;
    float* part; const bf16_t* sig;
    __device__ __forceinline__ void operator()(const f32x4 (&acc)[2][2][4][2], const Unit& u, int wr, int wc, int fr, int fq) const {
        const int row0 = u.pm * BM + wr * 64 + fr; const int col0 = u.pn * BM + wc * 32 + 8 * fq;
#pragma unroll
        for (int ai = 0; ai < 2; ++ai)
#pragma unroll
            for (int m = 0; m < 4; ++m) { const size_t r = (size_t)(row0 + ai * HALF + m * 16);
#pragma unroll
                for (int bj = 0; bj < 2; ++bj) { const int c = col0 + bj * HALF;
                    const u32x4e s = *(const u32x4e*)(sig + r * 2048 + c);
                    f32x4 v0 = acc[ai][bj][m][0], v1 = acc[ai][bj][m][1];
                    v0[0] *= bf_lo(s.x); v0[1] *= bf_hi(s.x); v0[2] *= bf_lo(s.y); v0[3] *= bf_hi(s.y);
                    v1[0] *= bf_lo(s.z); v1[1] *= bf_hi(s.z); v1[2] *= bf_lo(s.w); v1[3] *= bf_hi(s.w);
                    float* p = part + r * 2048 + c; *(f32x4*)p = v0; *(f32x4*)(p + 4) = v1; }
                asm volatile("" ::: "memory"); }
    }
};
struct EpiMerge {
    static constexpr bool PERM = true, AFTER_DRAIN = false;
    const float* part; const bf16_t* sig; bf16_t* O;
    __device__ __forceinline__ void operator()(const f32x4 (&acc)[2][2][4][2], const Unit& u, int wr, int wc, int fr, int fq) const {
        const int row0 = u.pm * BM + wr * 64 + fr; const int col0 = u.pn * BM + wc * 32 + 8 * fq;
#pragma unroll
        for (int ai = 0; ai < 2; ++ai)
#pragma unroll
            for (int m = 0; m < 4; ++m) { const size_t r = (size_t)(row0 + ai * HALF + m * 16);
#pragma unroll
                for (int bj = 0; bj < 2; ++bj) { const int c = col0 + bj * HALF;
                    const u32x4e s = *(const u32x4e*)(sig + r * 2048 + c);
                    const float* p = part + r * 2048 + c; const f32x4 p0 = *(const f32x4*)p, p1 = *(const f32x4*)(p + 4);
                    f32x4 v0 = acc[ai][bj][m][0], v1 = acc[ai][bj][m][1];
                    v0[0] = p0[0] + v0[0] * bf_lo(s.x); v0[1] = p0[1] + v0[1] * bf_hi(s.x); v0[2] = p0[2] + v0[2] * bf_lo(s.y); v0[3] = p0[3] + v0[3] * bf_hi(s.y);
                    v1[0] = p1[0] + v1[0] * bf_lo(s.z); v1[1] = p1[1] + v1[1] * bf_hi(s.z); v1[2] = p1[2] + v1[2] * bf_lo(s.w); v1[3] = p1[3] + v1[3] * bf_hi(s.w);
                    u32x4e w; w.x = cvt_pk_bf16(v0[0], v0[1]); w.y = cvt_pk_bf16(v0[2], v0[3]); w.z = cvt_pk_bf16(v1[0], v1[1]); w.w = cvt_pk_bf16(v1[2], v1[3]);
                    *(u32x4e*)(O + r * 2048 + c) = w; }
                asm volatile("" ::: "memory"); }
    }
};
struct EpiZ {
    static constexpr bool PERM = true, AFTER_DRAIN = false;
    const float* x; const float* gate; float* z; float alpha;
    __device__ __forceinline__ void operator()(const f32x4 (&acc)[2][2][4][2], const Unit& u, int wr, int wc, int fr, int fq) const {
        const int row0 = u.pm * BM + wr * 64 + fr; const int col0 = u.pn * BM + wc * 32 + 8 * fq;
#pragma unroll
        for (int bj = 0; bj < 2; ++bj) { const int c = col0 + bj * HALF;
            const f32x4 g0 = *(const f32x4*)(gate + c), g1 = *(const f32x4*)(gate + c + 4);
#pragma unroll
            for (int ai = 0; ai < 2; ++ai)
#pragma unroll
                for (int m = 0; m < 4; ++m) { const size_t r = (size_t)(row0 + ai * HALF + m * 16);
                    const float* xp = x + r * 2048 + c; const f32x4 x0 = *(const f32x4*)xp, x1 = *(const f32x4*)(xp + 4);
                    const f32x4 v0 = x0 * alpha + g0 * acc[ai][bj][m][0], v1 = x1 * alpha + g1 * acc[ai][bj][m][1];
                    float* zp = z + r * 2048 + c; *(f32x4*)zp = v0; *(f32x4*)(zp + 4) = v1;
                    asm volatile("" ::: "memory"); } }
    }
};

template <class Epi, class Sched, bool ALIGN_EPI = false, bool SP2 = false>
__device__ __forceinline__ void gemm_phase(PG8_LAS unsigned char* lds, const Gemm g, const Sched& S, const Epi& E) {
    const int tid = threadIdx.x, wid = __builtin_amdgcn_readfirstlane(tid >> 6), lane = tid & 63, wr = wid >> 2, wc = wid & 3, fr = lane & 15, fq = lane >> 4;
    const int K = g.K, nt = K / BK;
    unsigned voffA[2], voffB[2];
#pragma unroll
    for (int i = 0; i < 2; ++i) { int R, C; stage_rc(tid * 16 + i * 8192, R, C); const int Rb = Epi::PERM ? ((R & ~31) + perm32(R & 31)) : R;
        voffA[i] = (unsigned)(R * K + C) * 2u; voffB[i] = (unsigned)(Rb * K + C) * 2u; }
    const size_t kstep = (size_t)(BK * 2);
    const size_t hstep = (size_t)HALF * K * 2;
    const size_t tstep = 2 * hstep;
    const unsigned ldsw = (unsigned)wid * 1024u;
    const int aoff = lds_byte(wr * 64 + fr, fq * 8), boff = lds_byte(wc * 32 + fr, fq * 8);
#define PG8_SA(b, h) (((b) * 2 + (h)) * HTB)
#define PG8_SB(b, h) ((4 + (b) * 2 + (h)) * HTB)
#define PG8_STAGE(bufoff, gbase, voff) do { _Pragma("unroll") for (int _i = 0; _i < 2; ++_i) \
        __builtin_amdgcn_global_load_lds((const unsigned*)((const char*)(gbase) + (voff)[_i]), (PG8_LAS unsigned*)(lds + (bufoff) + ldsw + _i * 8192), 16, 0, 0); } while (0)
#define PG8_LDA(dst, b, h) do { _Pragma("unroll") for (int m = 0; m < 4; ++m) _Pragma("unroll") for (int k = 0; k < 2; ++k) dst[m][k] = *(const PG8_LAS bf16x8*)(lds + PG8_SA(b, h) + aoff + m * 2048 + k * 1024); } while (0)
#define PG8_LDB(dst, b, h) do { _Pragma("unroll") for (int n = 0; n < 2; ++n) _Pragma("unroll") for (int k = 0; k < 2; ++k) dst[n][k] = *(const PG8_LAS bf16x8*)(lds + PG8_SB(b, h) + boff + n * 2048 + k * 1024); } while (0)
#define PG8_MMA(ai, bj, At, Bt) do { __builtin_amdgcn_s_setprio(1); _Pragma("unroll") for (int m = 0; m < 4; ++m) _Pragma("unroll") for (int n = 0; n < 2; ++n) _Pragma("unroll") for (int k = 0; k < 2; ++k) \
        acc[ai][bj][m][n] = __builtin_amdgcn_mfma_f32_16x16x32_bf16(Bt[n][k], At[m][k], acc[ai][bj][m][n], 0, 0, 0); __builtin_amdgcn_s_setprio(0); } while (0)
#define PG8_WAIT_V(n) asm volatile("s_waitcnt vmcnt(" #n ")" ::: "memory")
#define PG8_WAIT_L(n) asm volatile("s_waitcnt lgkmcnt(" #n ")" ::: "memory")
#define PG8_BAR __builtin_amdgcn_s_barrier()
#define PG8_SCHED __builtin_amdgcn_sched_barrier(0)
    Unit cur, nxt; int ui = 0;
    if (!S.next(0, cur)) return;
    f32x4 acc[2][2][4][2];
#pragma unroll
    for (int a = 0; a < 2; ++a)
#pragma unroll
        for (int b = 0; b < 2; ++b)
#pragma unroll
            for (int m = 0; m < 4; ++m)
#pragma unroll
                for (int n = 0; n < 2; ++n) acc[a][b][m][n] = (f32x4){0.f, 0.f, 0.f, 0.f};
    bf16x8 At[4][2], B0[2][2], B1[2][2];
    const char* cA = (const char*)g.A + (size_t)cur.pm * tstep; const char* cB = (const char*)g.Bt + (size_t)cur.pn * tstep;
    S.a_ready(cur);
    if constexpr (SP2) {
        PG8_STAGE(PG8_SB(0, 0), cB, voffB); PG8_STAGE(PG8_SB(0, 1), cB + hstep, voffB); PG8_STAGE(PG8_SA(0, 0), cA, voffA); PG8_STAGE(PG8_SA(0, 1), cA + hstep, voffA);
        if (wr == 1) PG8_BAR;
        PG8_WAIT_V(2); PG8_BAR;
        PG8_STAGE(PG8_SB(1, 0), cB + kstep, voffB); PG8_STAGE(PG8_SA(1, 0), cA + kstep, voffA); PG8_STAGE(PG8_SB(1, 1), cB + hstep + kstep, voffB);
        PG8_WAIT_V(6); PG8_BAR;
    } else {
        PG8_STAGE(PG8_SB(0, 0), cB, voffB); PG8_STAGE(PG8_SA(0, 0), cA, voffA); PG8_STAGE(PG8_SB(0, 1), cB + hstep, voffB); PG8_STAGE(PG8_SA(0, 1), cA + hstep, voffA);
        if (wr == 1) PG8_BAR;
        PG8_WAIT_V(4); PG8_BAR;
        PG8_STAGE(PG8_SB(1, 0), cB + kstep, voffB); PG8_STAGE(PG8_SA(1, 0), cA + kstep, voffA); PG8_STAGE(PG8_SB(1, 1), cB + hstep + kstep, voffB);
        PG8_WAIT_V(6); PG8_BAR;
    }
    for (;;) {
        const bool has_next = S.next(ui + 1, nxt);
        const char* nA = has_next ? (const char*)g.A + (size_t)nxt.pm * tstep : cA; const char* nB = has_next ? (const char*)g.Bt + (size_t)nxt.pn * tstep : cB;
        for (int t = 0; t < nt; t += 2) {
            const bool last = (t == nt - 2);
            const char* a1 = cA + (size_t)(t + 1) * kstep;
            const char* a2 = last ? nA : cA + (size_t)(t + 2) * kstep; const char* b2 = last ? nB : cB + (size_t)(t + 2) * kstep;
            const char* a3 = a2 + kstep; const char* b3 = b2 + kstep;
            if (last && has_next) S.a_ready(nxt);
            if constexpr (SP2) {
            PG8_LDB(B0, 0, 0); PG8_LDB(B1, 0, 1); PG8_SCHED; PG8_LDA(At, 0, 0); PG8_STAGE(PG8_SA(1, 1), a1 + hstep, voffA);
            PG8_WAIT_V(8); PG8_WAIT_L(0); PG8_BAR; PG8_MMA(0, 0, At, B0); PG8_MMA(0, 1, At, B1); PG8_BAR; PG8_SCHED;
            PG8_LDA(At, 0, 1); PG8_STAGE(PG8_SB(0, 0), b2, voffB); PG8_STAGE(PG8_SB(0, 1), b2 + hstep, voffB); PG8_STAGE(PG8_SA(0, 0), a2, voffA);
            PG8_WAIT_V(8); PG8_WAIT_L(0); PG8_BAR; PG8_MMA(1, 0, At, B0); PG8_MMA(1, 1, At, B1); PG8_BAR; PG8_SCHED;
            PG8_LDB(B0, 1, 0); PG8_LDB(B1, 1, 1); PG8_SCHED; PG8_LDA(At, 1, 0); PG8_STAGE(PG8_SA(0, 1), a2 + hstep, voffA);
            PG8_WAIT_V(8); PG8_WAIT_L(0); PG8_BAR; PG8_MMA(0, 0, At, B0); PG8_MMA(0, 1, At, B1); PG8_BAR; PG8_SCHED;
            PG8_LDA(At, 1, 1); PG8_STAGE(PG8_SB(1, 0), b3, voffB); PG8_STAGE(PG8_SB(1, 1), b3 + hstep, voffB); PG8_STAGE(PG8_SA(1, 0), a3, voffA);
            PG8_WAIT_V(8); PG8_WAIT_L(0); PG8_BAR; PG8_MMA(1, 0, At, B0); PG8_MMA(1, 1, At, B1); PG8_BAR; PG8_SCHED;
            } else {
            PG8_LDB(B0, 0, 0); PG8_SCHED; PG8_LDA(At, 0, 0); PG8_STAGE(PG8_SA(1, 1), a1 + hstep, voffA);
            PG8_WAIT_L(8); PG8_BAR; PG8_WAIT_L(0); PG8_MMA(0, 0, At, B0); PG8_BAR; PG8_SCHED;
            PG8_LDB(B1, 0, 1); PG8_STAGE(PG8_SB(0, 0), b2, voffB);
            PG8_BAR; PG8_WAIT_L(0); PG8_MMA(0, 1, At, B1); PG8_BAR;
            PG8_LDA(At, 0, 1); PG8_STAGE(PG8_SA(0, 0), a2, voffA);
            PG8_BAR; PG8_WAIT_L(0); PG8_MMA(1, 0, At, B0); PG8_BAR; PG8_SCHED;
            PG8_STAGE(PG8_SB(0, 1), b2 + hstep, voffB);
            PG8_WAIT_V(6); PG8_BAR; PG8_MMA(1, 1, At, B1); PG8_BAR;
            PG8_LDB(B0, 1, 0); PG8_SCHED; PG8_LDA(At, 1, 0); PG8_STAGE(PG8_SA(0, 1), a2 + hstep, voffA);
            PG8_WAIT_L(8); PG8_BAR; PG8_WAIT_L(0); PG8_MMA(0, 0, At, B0); PG8_BAR; PG8_SCHED;
            PG8_LDB(B1, 1, 1); PG8_STAGE(PG8_SB(1, 0), b3, voffB);
            PG8_BAR; PG8_WAIT_L(0); PG8_MMA(0, 1, At, B1); PG8_BAR;
            PG8_LDA(At, 1, 1); PG8_STAGE(PG8_SA(1, 0), a3, voffA);
            PG8_BAR; PG8_WAIT_L(0); PG8_MMA(1, 0, At, B0); PG8_BAR; PG8_SCHED;
            PG8_STAGE(PG8_SB(1, 1), b3 + hstep, voffB);
            PG8_WAIT_V(6); PG8_BAR; PG8_MMA(1, 1, At, B1); PG8_BAR;
            }
        }
        if constexpr (ALIGN_EPI) { if (wr == 0) PG8_BAR; }
        if constexpr (!Epi::AFTER_DRAIN) { E(acc, cur, wr, wc, fr, fq); S.done(cur); }
        if (!has_next) break;
#pragma unroll
        for (int a = 0; a < 2; ++a)
#pragma unroll
            for (int b = 0; b < 2; ++b)
#pragma unroll
                for (int m = 0; m < 4; ++m)
#pragma unroll
                    for (int n = 0; n < 2; ++n) acc[a][b][m][n] = (f32x4){0.f, 0.f, 0.f, 0.f};
        cur = nxt; cA = nA; cB = nB; ++ui;
        if constexpr (ALIGN_EPI) { if (wr == 1) PG8_BAR; }
    }
    PG8_WAIT_V(0);
    if constexpr (!ALIGN_EPI) { if (wr == 0) PG8_BAR; }
    PG8_BAR;
    if constexpr (Epi::AFTER_DRAIN) { E.fused(acc, cur, wr, wc, fr, fq, lds, wid, lane); S.done(cur); }
#undef PG8_SA
#undef PG8_SB
#undef PG8_STAGE
#undef PG8_LDA
#undef PG8_LDB
#undef PG8_MMA
#undef PG8_WAIT_V
#undef PG8_WAIT_L
#undef PG8_BAR
#undef PG8_SCHED
}
}

#define GAS __attribute__((address_space(1)))
#define LAS __attribute__((address_space(3)))
typedef unsigned short bf16;
typedef unsigned v4u __attribute__((ext_vector_type(4)));
typedef unsigned v2u __attribute__((ext_vector_type(2)));
typedef float f32x4 __attribute__((ext_vector_type(4)));
typedef short bf16x8 __attribute__((ext_vector_type(8)));
typedef float f32x16 __attribute__((ext_vector_type(16)));
#define LDS_WAIT() asm volatile("s_waitcnt lgkmcnt(0)" ::: "memory")

constexpr int SEQ = 8192, DM = 2048, NIN = 10760, NWAVES = 8, NTHREADS = 512;
constexpr int LDP = pg8::LDP;
constexpr float LN_EPS = 1e-5f;
constexpr float LOG2E = 1.4426950408889634f;
constexpr float DN_ALPHA = 1.189207115002721f;
constexpr float NEG_BIG = -1e30f;

constexpr size_t MiB = 1u << 20;
constexpr size_t WS_ADA = 0;
constexpr size_t WS_BAR = 32 * 1024, WS_BAR_BYTES = 16 * 1024;
constexpr size_t WS_LOGF = 64 * 1024;
constexpr size_t WS_CUM = WS_LOGF + 256 * 1024;
constexpr size_t WS_WIN_T = 1 * MiB;
constexpr size_t WS_WBF_T = 44 * MiB;
constexpr size_t WS_WBS_T = 48 * MiB;
constexpr size_t WS_WOUT_T = 52 * MiB;
constexpr size_t WS_H = 64 * MiB;
constexpr size_t WS_PROJ = 96 * MiB;
constexpr size_t WS_AF = 264 * MiB;
constexpr size_t WS_AS = 280 * MiB;
constexpr size_t WS_END = 296 * MiB;

constexpr int LDS_BYTES = 147456, LDS_MISC_OFF = LDS_BYTES - 64;

__device__ __forceinline__ unsigned f2bf(float f) { unsigned u = __builtin_bit_cast(unsigned, f); return (u + 0x7fffu + ((u >> 16) & 1u)) >> 16; }
__device__ __forceinline__ unsigned pk2(float lo, float hi) { return f2bf(lo) | (f2bf(hi) << 16); }
__device__ __forceinline__ float bf2f(bf16 v) { return __builtin_bit_cast(float, (unsigned)v << 16); }
__device__ __forceinline__ float wave_sum(float v) {
#pragma unroll
    for (int o = 1; o < 64; o <<= 1) v += __shfl_xor(v, o);
    return v;
}
__device__ __forceinline__ float wave_max(float v) {
#pragma unroll
    for (int o = 1; o < 64; o <<= 1) v = fmaxf(v, __shfl_xor(v, o));
    return v;
}

struct Args { const float* in[12]; float* out; unsigned char* ws; int ph_lo, ph_hi; };

__device__ __forceinline__ void p0_transpose_item(const float* W, int K, int ldw, int N, bf16* WT, LAS float* scr, int item, int lane) {
    const int nblk = N / 32, kb = item / nblk, nb = item % nblk, k0 = 64 * kb, n0 = 32 * nb;
#pragma unroll 8
    for (int i = 0; i < 32; ++i) { const int kk = 2 * i + (lane >> 5); scr[kk * 33 + (lane & 31)] = W[(size_t)(k0 + kk) * ldw + n0 + (lane & 31)]; }
    LDS_WAIT(); asm volatile("" ::: "memory");
    const int c = lane & 7;
#pragma unroll
    for (int j = 0; j < 4; ++j) { const int n = (lane >> 3) + 8 * j; const LAS float* s = scr + (8 * c) * 33 + n;
        v4u o; o.x = pk2(s[0 * 33], s[1 * 33]); o.y = pk2(s[2 * 33], s[3 * 33]); o.z = pk2(s[4 * 33], s[5 * 33]); o.w = pk2(s[6 * 33], s[7 * 33]);
        *(v4u*)(WT + (size_t)(n0 + n) * K + k0 + 8 * c) = o; }
    LDS_WAIT(); asm volatile("" ::: "memory");
}

__device__ __forceinline__ void phase0(const Args& a, LAS unsigned char* lds) {
    const int tid = threadIdx.x, lane = tid & 63, wave = tid >> 6, G = gridDim.x;
    const float* c = a.in[1]; const float* w_ada = a.in[2]; const float* b_ada = a.in[3];
    float* ada = (float*)(a.ws + WS_ADA);
    LAS float* red = (LAS float*)lds;
    for (int cb = blockIdx.x; cb < 256; cb += G) {
        const int c4 = tid % 6, ks = tid / 6;
        f32x4 acc = {0.f, 0.f, 0.f, 0.f};
        if (ks < 85) {
            for (int k = ks; k < DM; k += 85) { const f32x4 w = *(const f32x4*)(w_ada + (size_t)k * 6144 + 24 * cb + 4 * c4); acc += w * c[k]; }
            *(LAS f32x4*)(red + ks * 24 + 4 * c4) = acc;
        }
        __syncthreads();
        if (tid < 24) { float s = 0.f; for (int i = 0; i < 85; ++i) s += red[i * 24 + tid]; ada[24 * cb + tid] = s + b_ada[24 * cb + tid]; }
        __syncthreads();
    }
    LAS float* scr = (LAS float*)(lds + wave * 16384);
    const int gw = blockIdx.x * NWAVES + wave, NGW = G * NWAVES;
    const float* w_in = a.in[4];
    constexpr int I_A = (DM / 64) * (3072 / 32), I_B = (DM / 64) * (7680 / 32), I_F = (1024 / 64) * (DM / 32), I_O = (DM / 64) * (DM / 32);
    constexpr int NITEMS = I_A + I_B + 2 * I_F + I_O;
    bf16* win_t = (bf16*)(a.ws + WS_WIN_T);
    for (int it = gw; it < NITEMS; it += NGW) {
        int r = it;
        if (r < I_A) { p0_transpose_item(w_in, DM, NIN, 3072, win_t, scr, r, lane); continue; } r -= I_A;
        if (r < I_B) { p0_transpose_item(w_in + 3080, DM, NIN, 7680, win_t + (size_t)3072 * DM, scr, r, lane); continue; } r -= I_B;
        if (r < I_F) { p0_transpose_item(a.in[7], 1024, DM, DM, (bf16*)(a.ws + WS_WBF_T), scr, r, lane); continue; } r -= I_F;
        if (r < I_F) { p0_transpose_item(a.in[8], 1024, DM, DM, (bf16*)(a.ws + WS_WBS_T), scr, r, lane); continue; } r -= I_F;
        p0_transpose_item(a.in[9], DM, DM, DM, (bf16*)(a.ws + WS_WOUT_T), scr, r, lane);
    }
}

__device__ __forceinline__ void phase1(const Args& a, LAS unsigned char* lds) {
    const int tid = threadIdx.x, lane = tid & 63, wave = tid >> 6, G = gridDim.x;
    const float* x = a.in[0]; const float* w_in = a.in[4]; const float* b_f = a.in[5];
    const float* ada = (const float*)(a.ws + WS_ADA);
    bf16* H = (bf16*)(a.ws + WS_H);
    float* logf_ = (float*)(a.ws + WS_LOGF);
    LAS f32x4* w8 = (LAS f32x4*)lds;
    for (int i = tid; i < 4096; i += NTHREADS) { const int k = i >> 1, half = i & 1; const int l = (k >> 2) & 63, e = k & 3, j = k >> 8;
        w8[((half * 4 + e) * 8 + j) * 64 + l] = *(const f32x4*)(w_in + (size_t)k * NIN + 3072 + 4 * half); }
    __syncthreads();
    const int gw = blockIdx.x * NWAVES + wave, NGW = G * NWAVES;
    for (int m = gw; m < SEQ; m += NGW) {
        const f32x4* xr = (const f32x4*)(x + (size_t)m * DM) + lane;
        f32x4 v[8]; float s = 0.f;
#pragma unroll
        for (int j = 0; j < 8; ++j) { v[j] = xr[64 * j]; s += (v[j].x + v[j].y) + (v[j].z + v[j].w); }
        const float mean = wave_sum(s) * (1.f / DM); float s2 = 0.f;
#pragma unroll
        for (int j = 0; j < 8; ++j) { v[j] = v[j] - mean; s2 += (v[j].x * v[j].x + v[j].y * v[j].y) + (v[j].z * v[j].z + v[j].w * v[j].w); }
        const float rstd = 1.f / sqrtf(wave_sum(s2) * (1.f / DM) + LN_EPS);
        f32x4 al = {0.f, 0.f, 0.f, 0.f}, ah = {0.f, 0.f, 0.f, 0.f};
        v2u* o8 = (v2u*)(H + (size_t)m * DM) + lane;
#pragma unroll
        for (int j = 0; j < 8; ++j) {
            asm volatile("" ::: "memory");
            const f32x4 sh = *((const f32x4*)ada + lane + 64 * j), sc = *((const f32x4*)(ada + DM) + lane + 64 * j);
            const f32x4 hv = v[j] * rstd * (sc + 1.0f) + sh;
            v2u o; o.x = pk2(hv.x, hv.y); o.y = pk2(hv.z, hv.w); o8[64 * j] = o;
#pragma unroll
            for (int e = 0; e < 4; ++e) { const f32x4 wl = w8[((0 + e) * 8 + j) * 64 + lane], wh = w8[((4 + e) * 8 + j) * 64 + lane]; al += wl * hv[e]; ah += wh * hv[e]; }
        }
        float r8[8] = {al.x, al.y, al.z, al.w, ah.x, ah.y, ah.z, ah.w};
#pragma unroll
        for (int hh = 0; hh < 8; ++hh) r8[hh] = wave_sum(r8[hh]);
        if (lane < 8) { float t = r8[0];
#pragma unroll
            for (int hh = 1; hh < 8; ++hh) t = (lane == hh) ? r8[hh] : t;
            const float xx = t + b_f[lane];
            logf_[lane * SEQ + m] = fminf(xx, 0.f) - log1pf(expf(-fabsf(xx))); }
    }
}

__device__ __forceinline__ void scan_head(const Args& a, LAS unsigned char* lds, int h) {
    const int tid = threadIdx.x;
    const float* src = (const float*)(a.ws + WS_LOGF) + (size_t)h * SEQ + 16 * tid;
    float* dst = (float*)(a.ws + WS_CUM) + (size_t)h * SEQ + 16 * tid;
    LAS float* tot = (LAS float*)lds;
    float v[16];
#pragma unroll
    for (int i = 0; i < 4; ++i) { const f32x4 t = *((const f32x4*)src + i); v[4 * i] = t.x; v[4 * i + 1] = t.y; v[4 * i + 2] = t.z; v[4 * i + 3] = t.w; }
#pragma unroll
    for (int i = 1; i < 16; ++i) v[i] += v[i - 1];
    tot[tid] = v[15];
    __syncthreads();
    float base = 0.f;
    for (int i = 0; i < tid; ++i) base += tot[i];
#pragma unroll
    for (int i = 0; i < 4; ++i) { f32x4 t = {v[4 * i] + base, v[4 * i + 1] + base, v[4 * i + 2] + base, v[4 * i + 3] + base}; *((f32x4*)dst + i) = t; }
    __syncthreads();
}

template <bool FOX>
__device__ __forceinline__ void naive_attn(const Args& a, LAS unsigned char* lds) {
    constexpr int D = FOX ? 128 : 64, NH = FOX ? 8 : 16;
    const int tid = threadIdx.x, lane = tid & 63, wave = tid >> 6, G = gridDim.x;
    const bf16* P = (const bf16*)(a.ws + WS_PROJ);
    const float* cum = (const float*)(a.ws + WS_CUM);
    const float* sinks = a.in[6];
    bf16* O = (bf16*)(a.ws + (FOX ? WS_AF : WS_AS));
    LAS float* qs = (LAS float*)(lds + wave * 1024);
    LAS float* ps = qs + 128;
    const int gw = blockIdx.x * NWAVES + wave, NGW = G * NWAVES;
    for (int row = gw; row < SEQ * NH; row += NGW) {
        const int t = row / NH, h = row % NH;
        const bf16* Qr = P + (FOX ? pg8::R_FQ : pg8::R_SQ) + ((size_t)h * SEQ + t) * D;
        const bf16* Kb = P + (FOX ? pg8::R_FK + (size_t)h * SEQ * D : pg8::R_SK + (size_t)(h >> 2) * SEQ * D);
        const bf16* Vb = P + (FOX ? pg8::R_FV + (size_t)h * SEQ * D : pg8::R_SV + (size_t)(h >> 2) * SEQ * D);
        const bf16* Gr = P + (FOX ? pg8::R_GF : pg8::R_GS) + (size_t)t * 1024 + h * D;
        if (FOX) { qs[2 * lane] = bf2f(Qr[2 * lane]); qs[2 * lane + 1] = bf2f(Qr[2 * lane + 1]); }
        else qs[lane] = bf2f(Qr[lane]);
        LDS_WAIT();
        const float Ft = FOX ? cum[h * SEQ + t] : 0.f;
        const float slope2 = FOX ? 0.f : exp2f(-8.0f * (float)(h + 1) / 16.0f) * LOG2E;
        const int lo = FOX ? 0 : (t - 127 > 0 ? t - 127 : 0);
        float mrun = NEG_BIG, l = 0.f, o0 = 0.f, o1 = 0.f;
        for (int s0 = lo; s0 <= t; s0 += 64) {
            const int s = s0 + lane; const bool valid = s <= t;
            float xv = NEG_BIG;
            if (valid) { const bf16* kr = Kb + (size_t)s * D; float dot = 0.f;
                for (int d = 0; d < D; d += 8) { const v4u kk = *(const v4u*)(kr + d);
                    dot += qs[d] * pg8::bf_lo(kk.x) + qs[d + 1] * pg8::bf_hi(kk.x) + qs[d + 2] * pg8::bf_lo(kk.y) + qs[d + 3] * pg8::bf_hi(kk.y)
                         + qs[d + 4] * pg8::bf_lo(kk.z) + qs[d + 5] * pg8::bf_hi(kk.z) + qs[d + 6] * pg8::bf_lo(kk.w) + qs[d + 7] * pg8::bf_hi(kk.w); }
                xv = FOX ? dot + (Ft - cum[h * SEQ + s]) * LOG2E : dot - slope2 * (float)(t - s); }
            const float mx = wave_max(xv), mnew = fmaxf(mrun, mx), alpha = exp2f(mrun - mnew);
            const float p = valid ? exp2f(xv - mnew) : 0.f;
            l = l * alpha + wave_sum(p); o0 *= alpha; o1 *= alpha; mrun = mnew;
            ps[lane] = p; LDS_WAIT();
            const int nj = (t - s0 + 1) < 64 ? (t - s0 + 1) : 64;
            for (int j = 0; j < nj; ++j) { const float pj = ps[j]; const bf16* vr = Vb + (size_t)(s0 + j) * D;
                if (FOX) { const unsigned vv = *(const unsigned*)(vr + 2 * lane); o0 += pj * pg8::bf_lo(vv); o1 += pj * pg8::bf_hi(vv); }
                else o0 += pj * bf2f(vr[lane]); }
            LDS_WAIT();
        }
        if (!FOX) l += exp2f(sinks[h] * LOG2E - mrun);
        const float inv = 1.f / l;
        if (FOX) { const unsigned gg = *(const unsigned*)(Gr + 2 * lane);
            *(unsigned*)(O + (size_t)t * 1024 + h * D + 2 * lane) = pk2(o0 * inv * pg8::bf_lo(gg), o1 * inv * pg8::bf_hi(gg)); }
        else O[(size_t)t * 1024 + h * D + lane] = (bf16)f2bf(o0 * inv * bf2f(Gr[lane]));
    }
}

__device__ __forceinline__ void phase_ln_out(const Args& a) {
    const int tid = threadIdx.x, lane = tid & 63, wave = tid >> 6, G = gridDim.x;
    const float* lng = a.in[10]; const float* lnb = a.in[11];
    const int gw = blockIdx.x * NWAVES + wave, NGW = G * NWAVES;
    for (int m = gw; m < SEQ; m += NGW) {
        f32x4* zr = (f32x4*)(a.out + (size_t)m * DM) + lane;
        f32x4 v[8]; float s = 0.f;
#pragma unroll
        for (int j = 0; j < 8; ++j) { v[j] = zr[64 * j]; s += (v[j].x + v[j].y) + (v[j].z + v[j].w); }
        const float mean = wave_sum(s) * (1.f / DM); float s2 = 0.f;
#pragma unroll
        for (int j = 0; j < 8; ++j) { v[j] = v[j] - mean; s2 += (v[j].x * v[j].x + v[j].y * v[j].y) + (v[j].z * v[j].z + v[j].w * v[j].w); }
        const float rstd = 1.f / sqrtf(wave_sum(s2) * (1.f / DM) + LN_EPS);
#pragma unroll
        for (int j = 0; j < 8; ++j) { const f32x4 g = *((const f32x4*)lng + lane + 64 * j), b = *((const f32x4*)lnb + lane + 64 * j); zr[64 * j] = v[j] * rstd * g + b; }
    }
}

#define XB_TMO      128
#define XB_XCNT(j)  (256  + 64 * (j))
#define XB_XSUB(j)  (1280 + 64 * (j))
#define XB_XGEN(j)  (2304 + 64 * (j))
#define XB_TOP      3328
#define XB_TOPGEN   3392
#define XCD_BAR_WORDS 3456
#define XB_SPIN_CAP (1u << 18)

__device__ __forceinline__ unsigned xb_ld(unsigned* p)              { return __hip_atomic_load(p, __ATOMIC_RELAXED, __HIP_MEMORY_SCOPE_AGENT); }
__device__ __forceinline__ unsigned xb_add(unsigned* p, unsigned v) { return __hip_atomic_fetch_add(p, v, __ATOMIC_RELAXED, __HIP_MEMORY_SCOPE_AGENT); }
__device__ __forceinline__ unsigned xb_xcc_id() { return (unsigned)__builtin_amdgcn_s_getreg((3 << 11) | 20) & 0xFu; }
#define XB_SPIN(cond, bar) do { unsigned _sp = 0; while (cond) { __builtin_amdgcn_s_sleep(1); \
    if ((++_sp & 255u) == 0u) { if (xb_ld(&(bar)[XB_TMO])) break; if (_sp > XB_SPIN_CAP) { atomicAdd(&(bar)[XB_TMO], 1u); break; } } } } while (0)

struct XcdBarrier {
    unsigned* bar; unsigned x;
    volatile LAS unsigned* st;
};

__device__ __forceinline__ XcdBarrier xcd_barrier_post(unsigned* bar, volatile LAS unsigned* st) {
    XcdBarrier b; b.bar = bar; b.x = xb_xcc_id(); b.st = st;
    if (threadIdx.x == 0) (void)xb_add(&bar[XB_XCNT(b.x)], 1u);
    return b;
}
__device__ __forceinline__ void xcd_barrier_complete(unsigned* bar, unsigned x, unsigned& nloc, unsigned& nx) {
    const unsigned G = gridDim.x * gridDim.y * gridDim.z;
    unsigned sum, cnt, mine, sp = 0u;
    for (;;) {
        sum = 0u; cnt = 0u; mine = 0u;
#pragma unroll
        for (unsigned j = 0; j < 16; ++j) { const unsigned c = xb_ld(&bar[XB_XCNT(j)]); sum += c; cnt += (c > 0u) ? 1u : 0u; mine = (j == x) ? c : mine; }
        if (sum == G) break;
        __builtin_amdgcn_s_sleep(1);
        if ((++sp & 255u) == 0u) { if (xb_ld(&bar[XB_TMO])) break; if (sp > XB_SPIN_CAP) { atomicAdd(&bar[XB_TMO], 1u); break; } }
    }
    nloc = mine > 0u ? mine : 1u; nx = cnt > 0u ? cnt : 1u;
}

__device__ __forceinline__ void xcd_barrier(const XcdBarrier& b) {
    asm volatile("s_waitcnt vmcnt(0)" ::: "memory");
    __syncthreads();
    if (threadIdx.x == 0) {
        unsigned* bar = b.bar;
        __builtin_amdgcn_s_waitcnt(0);
        unsigned nloc = b.st[0], nx = b.st[1];
        if (nloc == 0u) { xcd_barrier_complete(bar, b.x, nloc, nx); b.st[0] = nloc; b.st[1] = nx; }
        const unsigned old = xb_add(&bar[XB_XSUB(b.x)], 1u);
        const unsigned gen = old / nloc;
        if (old + 1u == (gen + 1u) * nloc) {
            __builtin_amdgcn_fence(__ATOMIC_RELEASE, "agent");
            asm volatile("s_waitcnt vmcnt(0)" ::: "memory");
            const unsigned og = xb_add(&bar[XB_TOP], 1u);
            const unsigned tg = og / nx;
            if (og + 1u == (tg + 1u) * nx) xb_add(&bar[XB_TOPGEN], 1u);
            else XB_SPIN(xb_ld(&bar[XB_TOPGEN]) == tg, bar);
            __builtin_amdgcn_fence(__ATOMIC_ACQUIRE, "agent");
            xb_add(&bar[XB_XGEN(b.x)], 1u);
            asm volatile("s_waitcnt vmcnt(0)" ::: "memory");
        } else {
            XB_SPIN(xb_ld(&bar[XB_XGEN(b.x)]) == gen, bar);
            __builtin_amdgcn_fence(__ATOMIC_ACQUIRE, "agent");
            asm volatile("s_waitcnt vmcnt(0)" ::: "memory");
        }
    }
    __syncthreads();
}


typedef short s16x4 __attribute__((ext_vector_type(4)));
typedef short v4i16_t __attribute__((ext_vector_type(4)));
typedef float f32x2_t __attribute__((ext_vector_type(2)));
typedef __bf16 bf16x2_t __attribute__((ext_vector_type(2)));
#define MFMA32(a, b, c) __builtin_amdgcn_mfma_f32_32x32x16_bf16((a), (b), (c), 0, 0, 0)
__device__ __forceinline__ s16x4 vtr(LAS const unsigned char* p) { return __builtin_bit_cast(s16x4, __builtin_amdgcn_ds_read_tr16_b64_v4i16((LAS v4i16_t*)p)); }
__device__ __forceinline__ unsigned cvtpk(float lo, float hi) { f32x2_t v = {lo, hi}; bf16x2_t b = __builtin_convertvector(v, bf16x2_t); return __builtin_bit_cast(unsigned, b); }
__device__ __forceinline__ float xor32_max(float v) { auto rr = __builtin_amdgcn_permlane32_swap(__float_as_uint(v), __float_as_uint(v), false, false); return fmaxf(__uint_as_float(rr[0]), __uint_as_float(rr[1])); }
__device__ __forceinline__ float xor32_sum(float v) { auto rr = __builtin_amdgcn_permlane32_swap(__float_as_uint(v), __float_as_uint(v), false, false); return __uint_as_float(rr[0]) + __uint_as_float(rr[1]); }
__device__ __forceinline__ int crow(int i, int h) { return (i & 3) + 8 * (i >> 2) + 4 * h; }

template <bool FOX> struct AC {
    static constexpr int D = FOX ? 128 : 64, NDS = D / 16, NDB = D / 32;
    static constexpr int ROWB = D * 2;
    static constexpr int OFF_K = 0, OFF_V = 128 * ROWB, OFF_B = 2 * 128 * ROWB, BUF = OFF_B + 512;
    static constexpr int CPR = D / 8;
    static constexpr int NP = (128 * CPR / 64) / NWAVES;
    static constexpr int W = FOX ? (1 << 30) : 128;
    __device__ static __forceinline__ int swzK(int row) { return FOX ? (row & 15) : ((row >> 1) & 7); }
    __device__ static __forceinline__ int swzV(int row) { return FOX ? (row & 3) : ((row >> 1) & 1); }
};
__device__ __forceinline__ void glds16(const void* gsrc, unsigned lds_dst) { unsigned keep;
    asm volatile("s_mov_b32 %0, m0\n\ts_mov_b32 m0, %2\n\ts_nop 0\n\tglobal_load_lds_dwordx4 %1, off\n\ts_mov_b32 m0, %0" : "=&s"(keep) : "v"(gsrc), "s"(lds_dst) : "memory"); }
#define WAIT_ALL_BAR() asm volatile("s_waitcnt vmcnt(0) lgkmcnt(0)\n\ts_barrier" ::: "memory")
template <bool FOX>
__device__ __forceinline__ void dma_step(const bf16* Pk, const bf16* Pv, int key0, unsigned ldsbuf, int wave, int lane) {
    typedef AC<FOX> C;
#pragma unroll
    for (int i = 0; i < C::NP; ++i) { const int piece = wave * C::NP + i, L = piece * 64 + lane, row = L / C::CPR, cp = L % C::CPR;
        const int kc = cp ^ C::swzK(row), vc = ((((cp >> 2) ^ C::swzV(row)) << 2) | (cp & 3));
        const size_t ro = (size_t)(key0 + row) * C::D;
        glds16(Pk + ro + kc * 8, (unsigned)__builtin_amdgcn_readfirstlane(ldsbuf + C::OFF_K + piece * 1024));
        glds16(Pv + ro + vc * 8, (unsigned)__builtin_amdgcn_readfirstlane(ldsbuf + C::OFF_V + piece * 1024)); }
}

template <bool FOX>
__device__ __forceinline__ bool attn_tileA(LAS const unsigned char* Kb, LAS const float* Bb,
                                           const bf16x8 (&qf)[AC<FOX>::NDS], f32x16 (&oT)[AC<FOX>::NDB], float& m, float& l, bf16x8 (&pf)[2][2],
                                           int ka, int ta, int lane, float slope2) {
    typedef AC<FOX> C;
    const int dmax = ta + 31 - ka, dmin = ta - ka - 63;
    if (dmax < 0 || dmin >= C::W) return false;
    const bool need_mask = (dmin < 0) || (dmax >= C::W);
    const int r = lane & 31, h = lane >> 5;
    f32x16 s0, s1;
    if (FOX) {
#pragma unroll
        for (int g4 = 0; g4 < 4; ++g4) { const f32x4 b0 = *(LAS const f32x4*)(Bb + 8 * g4 + 4 * h), b1 = *(LAS const f32x4*)(Bb + 32 + 8 * g4 + 4 * h);
#pragma unroll
            for (int e = 0; e < 4; ++e) { s0[4 * g4 + e] = b0[e]; s1[4 * g4 + e] = b1[e]; } }
    } else {
#pragma unroll
        for (int i = 0; i < 16; ++i) { s0[i] = 0.f; s1[i] = 0.f; }
    }
    LAS const unsigned char* kp = Kb + r * C::ROWB; const int kx = (h ^ C::swzK(r)) * 16;
#pragma unroll
    for (int ds = 0; ds < C::NDS; ++ds) {
        const bf16x8 k0 = *(LAS const bf16x8*)(kp + (kx ^ (ds * 32))), k1 = *(LAS const bf16x8*)(kp + 32 * C::ROWB + (kx ^ (ds * 32)));
        s0 = MFMA32(k0, qf[ds], s0); s1 = MFMA32(k1, qf[ds], s1);
    }
    const int tl = ta + r - ka;
    if (!FOX) {
#pragma unroll
        for (int i = 0; i < 16; ++i) { const float d0 = (float)(tl - crow(i, h)); s0[i] -= slope2 * d0; s1[i] -= slope2 * (d0 - 32.f); }
    }
    if (need_mask) {
#pragma unroll
        for (int i = 0; i < 16; ++i) { const int d0 = tl - crow(i, h), d1 = d0 - 32;
            if (d0 < 0 || d0 >= C::W) s0[i] = -1e30f;
            if (d1 < 0 || d1 >= C::W) s1[i] = -1e30f; }
    }
    float mx = fmaxf(s0[0], s1[0]);
#pragma unroll
    for (int i = 1; i < 16; ++i) mx = fmaxf(mx, fmaxf(s0[i], s1[i]));
    mx = xor32_max(mx);
    const float mnew = fmaxf(m, mx), alpha = __builtin_amdgcn_exp2f(m - mnew);
    m = mnew;
    float ps = 0.f;
#pragma unroll
    for (int i = 0; i < 16; ++i) { s0[i] = __builtin_amdgcn_exp2f(s0[i] - mnew); s1[i] = __builtin_amdgcn_exp2f(s1[i] - mnew); ps += s0[i] + s1[i]; }
    l = l * alpha + ps;
#pragma unroll
    for (int db = 0; db < C::NDB; ++db) oT[db] = oT[db] * alpha;
#pragma unroll
    for (int s = 0; s < 2; ++s) {
        v4u a, b;
        a.x = cvtpk(s0[8 * s], s0[8 * s + 1]); a.y = cvtpk(s0[8 * s + 2], s0[8 * s + 3]); a.z = cvtpk(s0[8 * s + 4], s0[8 * s + 5]); a.w = cvtpk(s0[8 * s + 6], s0[8 * s + 7]);
        b.x = cvtpk(s1[8 * s], s1[8 * s + 1]); b.y = cvtpk(s1[8 * s + 2], s1[8 * s + 3]); b.z = cvtpk(s1[8 * s + 4], s1[8 * s + 5]); b.w = cvtpk(s1[8 * s + 6], s1[8 * s + 7]);
        pf[0][s] = __builtin_bit_cast(bf16x8, a); pf[1][s] = __builtin_bit_cast(bf16x8, b);
    }
    return true;
}
template <bool FOX>
__device__ __forceinline__ void attn_tileB(LAS const unsigned char* Vb, f32x16 (&oT)[AC<FOX>::NDB], const bf16x8 (&pf)[2][2], int lane) {
    typedef AC<FOX> C;
    const int h = lane >> 5;
    const int i16 = lane & 15, qq = i16 >> 2, pp = i16 & 3, blk = (lane >> 4) & 1;
    const int l0 = (4 * h + qq) * C::ROWB + C::swzV(qq) * 64 + 32 * blk + 8 * pp;
#pragma unroll
    for (int db = 0; db < C::NDB; ++db) {
        LAS const unsigned char* vp = Vb + (l0 ^ (db * 64));
#pragma unroll
        for (int b = 0; b < 2; ++b)
#pragma unroll
            for (int s = 0; s < 2; ++s) {
                const s16x4 lo = vtr(vp + (32 * b + 16 * s) * C::ROWB), hi = vtr(vp + (32 * b + 16 * s + 8) * C::ROWB);
                const bf16x8 va = __builtin_shufflevector(lo, hi, 0, 1, 2, 3, 4, 5, 6, 7);
                oT[db] = MFMA32(va, pf[b][s], oT[db]);
            }
    }
}

__device__ __forceinline__ void fox_unit(const Args& a, LAS unsigned char* lds, int hd, int qb) {
    typedef AC<true> C;
    const int tid = threadIdx.x, lane = tid & 63, wave = __builtin_amdgcn_readfirstlane(tid >> 6), rg = wave & 3, g = wave >> 2;
    const int r = lane & 31, hh = lane >> 5;
    const bf16* P = (const bf16*)(a.ws + WS_PROJ);
    const bf16* Pq = P + pg8::R_FQ + (size_t)hd * SEQ * 128; const bf16* Pk = P + pg8::R_FK + (size_t)hd * SEQ * 128; const bf16* Pv = P + pg8::R_FV + (size_t)hd * SEQ * 128; const bf16* Pg = P + pg8::R_GF + hd * 128;
    const float* cumh = (const float*)(a.ws + WS_CUM) + (size_t)hd * SEQ;
    bf16* O = (bf16*)(a.ws + WS_AF);
    const int q0 = 128 * qb, tq = q0 + 32 * rg + r;
    bf16x8 qf[C::NDS];
#pragma unroll
    for (int ds = 0; ds < C::NDS; ++ds) qf[ds] = *(const bf16x8*)(Pq + (size_t)tq * C::D + ds * 16 + hh * 8);
    const float Fq0 = cumh[q0];
    f32x16 oT[C::NDB];
#pragma unroll
    for (int db = 0; db < C::NDB; ++db)
#pragma unroll
        for (int i = 0; i < 16; ++i) oT[db][i] = 0.f;
    float m = -1e20f, l = 0.f;
    const unsigned lds0 = (unsigned)(uintptr_t)lds;
    float breg = 0.f;
    dma_step<true>(Pk, Pv, 0, lds0, wave, lane);
    if (tid < 128) { breg = cumh[tid]; ((LAS float*)(lds + C::OFF_B))[tid] = (Fq0 - breg) * LOG2E; }
    WAIT_ALL_BAR();
#pragma unroll
    for (int ds = 0; ds < C::NDS; ++ds) asm volatile("" : "+v"(qf[ds]));
    for (int s = 0; s <= qb; ++s) {
        const int cur = (s & 1) * C::BUF, nxt = C::BUF - cur;
        { const int nk = 128 * (s + 1) < SEQ - 128 ? 128 * (s + 1) : SEQ - 128; breg = cumh[nk + (tid & 127)]; }
        if (s < qb) dma_step<true>(Pk, Pv, 128 * (s + 1), lds0 + nxt, wave, lane);
        bf16x8 pf[2][2];
        if (attn_tileA<true>(lds + cur + C::OFF_K + 64 * g * C::ROWB, (LAS const float*)(lds + cur + C::OFF_B) + 64 * g, qf, oT, m, l, pf, 128 * s + 64 * g, q0 + 32 * rg, lane, 0.f))
            attn_tileB<true>(lds + cur + C::OFF_V + 64 * g * C::ROWB, oT, pf, lane);
        const float bval = (Fq0 - breg) * LOG2E; asm volatile("" :: "v"(bval));
        if (s < qb && tid < 128) ((LAS float*)(lds + nxt + C::OFF_B))[tid] = bval;
        WAIT_ALL_BAR();
    }
    LAS float* mg = (LAS float*)lds + rg * (66 * 64) + lane;
    if (g == 1) {
#pragma unroll
        for (int db = 0; db < C::NDB; ++db)
#pragma unroll
            for (int i = 0; i < 16; ++i) mg[(db * 16 + i) * 64] = oT[db][i];
        mg[64 * 64] = m; mg[65 * 64] = l;
    }
    __syncthreads();
    if (g == 0) {
        const float m1 = mg[64 * 64], l1 = mg[65 * 64], mt = fmaxf(m, m1), a0 = __builtin_amdgcn_exp2f(m - mt), a1 = __builtin_amdgcn_exp2f(m1 - mt);
        const float inv = 1.0f / xor32_sum(a0 * l + a1 * l1);
        const float s0 = a0 * inv, s1 = a1 * inv;
#pragma unroll
        for (int db = 0; db < C::NDB; ++db)
#pragma unroll
            for (int g4 = 0; g4 < 4; ++g4) { const int d = 32 * db + 8 * g4 + 4 * hh;
                asm volatile("" ::: "memory");
                const v2u gg = *(const v2u*)(Pg + (size_t)tq * 1024 + d);
                const float o0 = (s0 * oT[db][4 * g4] + s1 * mg[(db * 16 + 4 * g4) * 64]) * pg8::bf_lo(gg.x), o1 = (s0 * oT[db][4 * g4 + 1] + s1 * mg[(db * 16 + 4 * g4 + 1) * 64]) * pg8::bf_hi(gg.x);
                const float o2 = (s0 * oT[db][4 * g4 + 2] + s1 * mg[(db * 16 + 4 * g4 + 2) * 64]) * pg8::bf_lo(gg.y), o3 = (s0 * oT[db][4 * g4 + 3] + s1 * mg[(db * 16 + 4 * g4 + 3) * 64]) * pg8::bf_hi(gg.y);
                v2u w; w.x = cvtpk(o0, o1); w.y = cvtpk(o2, o3);
                *(v2u*)(O + (size_t)tq * 1024 + hd * 128 + d) = w; }
    }
    __syncthreads();
}

__device__ __forceinline__ void swa_unit(const Args& a, LAS unsigned char* lds, int nb, int hp) {
    typedef AC<false> C;
    const int tid = threadIdx.x, lane = tid & 63, wave = __builtin_amdgcn_readfirstlane(tid >> 6), rg = wave & 3, g = wave >> 2;
    const int r = lane & 31, hh = lane >> 5;
    const int head = 2 * hp + g, kvh = hp >> 1;
    const bf16* P = (const bf16*)(a.ws + WS_PROJ);
    const bf16* Pq = P + pg8::R_SQ + (size_t)head * SEQ * 64; const bf16* Pk = P + pg8::R_SK + (size_t)kvh * SEQ * 64; const bf16* Pv = P + pg8::R_SV + (size_t)kvh * SEQ * 64; const bf16* Pg = P + pg8::R_GS + head * 64;
    bf16* O = (bf16*)(a.ws + WS_AS);
    const int q0 = 128 * nb, tq = q0 + 32 * rg + r;
    const float slope2 = exp2f(-8.0f * (float)(head + 1) / 16.0f) * LOG2E;
    bf16x8 qf[C::NDS];
#pragma unroll
    for (int ds = 0; ds < C::NDS; ++ds) qf[ds] = *(const bf16x8*)(Pq + (size_t)tq * C::D + ds * 16 + hh * 8);
    f32x16 oT[C::NDB];
#pragma unroll
    for (int db = 0; db < C::NDB; ++db)
#pragma unroll
        for (int i = 0; i < 16; ++i) oT[db][i] = 0.f;
    float m = -1e20f, l = 0.f;
    const unsigned lds0 = (unsigned)(uintptr_t)lds;
    const int sfirst = nb > 0 ? nb - 1 : 0;
    dma_step<false>(Pk, Pv, 128 * sfirst, lds0, wave, lane);
    WAIT_ALL_BAR();
#pragma unroll
    for (int ds = 0; ds < C::NDS; ++ds) asm volatile("" : "+v"(qf[ds]));
    for (int s = sfirst; s <= nb; ++s) {
        const int cur = ((s - sfirst) & 1) * C::BUF, nxt = C::BUF - cur;
        if (s < nb) dma_step<false>(Pk, Pv, 128 * (s + 1), lds0 + nxt, wave, lane);
#pragma unroll 1
        for (int jt = 0; jt < 2; ++jt)
        { bf16x8 pf[2][2];
            if (attn_tileA<false>(lds + cur + C::OFF_K + 64 * jt * C::ROWB, nullptr, qf, oT, m, l, pf, 128 * s + 64 * jt, q0 + 32 * rg, lane, slope2))
                attn_tileB<false>(lds + cur + C::OFF_V + 64 * jt * C::ROWB, oT, pf, lane); }
        WAIT_ALL_BAR();
    }
    const float inv = 1.0f / (xor32_sum(l) + __builtin_amdgcn_exp2f(a.in[6][head] * LOG2E - m));
#pragma unroll
    for (int db = 0; db < C::NDB; ++db)
#pragma unroll
        for (int g4 = 0; g4 < 4; ++g4) { const int d = 32 * db + 8 * g4 + 4 * hh;
            const v2u gg = *(const v2u*)(Pg + (size_t)tq * 1024 + d);
            const float o0 = oT[db][4 * g4] * inv * pg8::bf_lo(gg.x), o1 = oT[db][4 * g4 + 1] * inv * pg8::bf_hi(gg.x), o2 = oT[db][4 * g4 + 2] * inv * pg8::bf_lo(gg.y), o3 = oT[db][4 * g4 + 3] * inv * pg8::bf_hi(gg.y);
            v2u w; w.x = cvtpk(o0, o1); w.y = cvtpk(o2, o3);
            *(v2u*)(O + (size_t)tq * 1024 + head * 64 + d) = w; }
}

#ifndef ATTN_FOX_FAST
#define ATTN_FOX_FAST 1
#endif
#ifndef ATTN_SWA_FAST
#define ATTN_SWA_FAST 1
#endif
__device__ __forceinline__ void phase_attn(const Args& a, LAS unsigned char* lds) {
    const int G = gridDim.x;
#if ATTN_FOX_FAST
    for (int p = blockIdx.x; p < 256; p += G) { const int hd = p & 7, j = p >> 3;
#pragma unroll 1
        for (int k = 0; k < 2; ++k) fox_unit(a, lds, hd, k ? j : 63 - j); }
#else
    naive_attn<true>(a, lds);
#endif
    __syncthreads();
#if ATTN_SWA_FAST
    for (int u = blockIdx.x; u < 512; u += G) { const int hp = u & 7, nb = u >> 3; swa_unit(a, lds, nb, hp); }
#else
    naive_attn<false>(a, lds);
#endif
}

constexpr int N_PHASES = 7;
__global__ void __launch_bounds__(NTHREADS) fwd_megakernel(Args args) {
    extern __shared__ __attribute__((aligned(16))) unsigned char lds_raw[];
    LAS unsigned char* lds = (LAS unsigned char*)lds_raw;
    cg::grid_group grid = cg::this_grid();
    const int lo = args.ph_lo, hi = args.ph_hi;
    const bool one = (lo == 0 && hi == N_PHASES);
    unsigned char* ws = args.ws;
    volatile LAS unsigned* misc = (volatile LAS unsigned*)(lds + LDS_MISC_OFF);
    if (threadIdx.x < 16) misc[threadIdx.x] = 0u;
    __syncthreads();
    XcdBarrier bar; bar.bar = (unsigned*)(ws + WS_BAR); bar.x = 0; bar.st = misc;
    if (one) bar = xcd_barrier_post((unsigned*)(ws + WS_BAR), misc);
#define IN(k) (lo <= (k) && (k) < hi)
#define SEAM_CG() do { if (one) grid.sync(); } while (0)
#define SEAM() do { if (one) xcd_barrier(bar); } while (0)
    if (IN(0)) { phase0(args, lds); SEAM_CG(); }
    if (IN(1)) { phase1(args, lds); SEAM(); }
    if (IN(2)) {
        if (blockIdx.x < 8) scan_head(args, lds, blockIdx.x);
        pg8::Gemm g{(const pg8::bf16_t*)(ws + WS_H), (const pg8::bf16_t*)(ws + WS_WIN_T), SEQ, LDP, DM};
        pg8::StaticOrder S; S.init(SEQ, LDP, gridDim.x, (int)blockIdx.x);
        pg8::EpiProj E{(pg8::bf16_t*)(ws + WS_PROJ)};
        pg8::gemm_phase<pg8::EpiProj, pg8::StaticOrder, true, true>(lds, g, S, E);
        SEAM();
    }
    if (IN(3)) { phase_attn(args, lds); SEAM(); }
    if (IN(4)) {
        pg8::StaticOrder S; S.init(SEQ, DM, gridDim.x, (int)blockIdx.x);
        { pg8::Gemm g{(const pg8::bf16_t*)(ws + WS_AF), (const pg8::bf16_t*)(ws + WS_WBF_T), SEQ, DM, 1024};
          pg8::EpiPartial E{args.out, (const pg8::bf16_t*)(ws + WS_PROJ) + pg8::R_MF};
          pg8::gemm_phase<pg8::EpiPartial, pg8::StaticOrder, true, true>(lds, g, S, E); }
        __syncthreads();
        { pg8::Gemm g{(const pg8::bf16_t*)(ws + WS_AS), (const pg8::bf16_t*)(ws + WS_WBS_T), SEQ, DM, 1024};
          pg8::EpiMerge E{args.out, (const pg8::bf16_t*)(ws + WS_PROJ) + pg8::R_MS, (pg8::bf16_t*)(ws + WS_H)};
          pg8::gemm_phase<pg8::EpiMerge, pg8::StaticOrder, true, true>(lds, g, S, E); }
        SEAM();
    }
    if (IN(5)) {
        pg8::StaticOrder S; S.init(SEQ, DM, gridDim.x, (int)blockIdx.x);
        pg8::Gemm g{(const pg8::bf16_t*)(ws + WS_H), (const pg8::bf16_t*)(ws + WS_WOUT_T), SEQ, DM, DM};
        pg8::EpiZ E{args.in[0], (const float*)(ws + WS_ADA) + 2 * DM, args.out, DN_ALPHA};
        pg8::gemm_phase<pg8::EpiZ, pg8::StaticOrder, true, true>(lds, g, S, E);
        SEAM();
    }
    if (IN(6)) { phase_ln_out(args); }
#undef IN
#undef SEAM
#undef SEAM_CG
}

#ifndef MK_N_LAUNCHES
#define MK_N_LAUNCHES 1
#endif
extern "C" void kernel_launch(void* const* d_in, const int* in_sizes, int n_in, void* d_out, int out_size, void* d_ws, size_t ws_size, hipStream_t stream) {
    static int grid = 0;
    if (grid == 0) {
        if (n_in != 12 || out_size != SEQ * DM || ws_size < WS_END) { fprintf(stderr, "kernel_launch: unexpected shapes (n_in %d out %d ws %zu)\n", n_in, out_size, ws_size); grid = -1; return; }
        int dev = 0, cus = 0, per_cu = 0;
        hipGetDevice(&dev);
        hipDeviceGetAttribute(&cus, hipDeviceAttributeMultiprocessorCount, dev);
        if (hipFuncSetAttribute((const void*)fwd_megakernel, hipFuncAttributeMaxDynamicSharedMemorySize, LDS_BYTES) != hipSuccess) { fprintf(stderr, "kernel_launch: hipFuncSetAttribute failed\n"); grid = -1; return; }
        if (hipOccupancyMaxActiveBlocksPerMultiprocessor(&per_cu, (const void*)fwd_megakernel, NTHREADS, LDS_BYTES) != hipSuccess || per_cu < 1) { fprintf(stderr, "kernel_launch: occupancy query says %d\n", per_cu); per_cu = 1; }
        (void)hipGetLastError();
        grid = cus * (per_cu > 1 ? 1 : per_cu);
        fprintf(stderr, "kernel_launch: grid %d (cus %d per_cu %d)\n", grid, cus, per_cu);
    }
    if (grid < 0) return;
    Args a{};
    for (int i = 0; i < 12; ++i) a.in[i] = (const float*)d_in[i];
    a.out = (float*)d_out; a.ws = (unsigned char*)d_ws;
#if MK_N_LAUNCHES == 1
    if (hipMemsetAsync((char*)d_ws + WS_BAR, 0, WS_BAR_BYTES, stream) != hipSuccess) { fprintf(stderr, "kernel_launch: memset failed\n"); return; }
    a.ph_lo = 0; a.ph_hi = N_PHASES;
    void* kargs[] = {&a};
    hipError_t e = hipLaunchCooperativeKernel((const void*)fwd_megakernel, dim3(grid), dim3(NTHREADS), kargs, LDS_BYTES, stream);
    if (e != hipSuccess) fprintf(stderr, "cooperative launch failed: %s (grid %d)\n", hipGetErrorString(e), grid);
#else
#ifndef PROBE_REP
#define PROBE_REP -1
#endif
    for (int p = 0; p < N_PHASES; ++p) { a.ph_lo = p; a.ph_hi = p + 1;
        for (int rep = 0; rep < (p == PROBE_REP ? 2 : 1); ++rep) hipLaunchKernelGGL(fwd_megakernel, dim3(grid), dim3(NTHREADS), LDS_BYTES, stream, a); }
#endif
}
```

```cpp
#include <hip/hip_runtime.h>
#include <hip/hip_cooperative_groups.h>
#include <cstdio>
#include <cstdint>
#include <cmath>
namespace cg = cooperative_groups;
namespace pg8 {
#define PG8_LAS __attribute__((address_space(3)))
typedef unsigned short bf16_t;
typedef short bf16x8 __attribute__((ext_vector_type(8)));
typedef float f32x4 __attribute__((ext_vector_type(4)));
typedef unsigned u32x4 __attribute__((ext_vector_type(4)));
constexpr int BM = 256, BK = 64, HALF = 128, HTB = HALF * BK * 2  , STAGE_BYTES = 8 * HTB, NXCD = 8, WGM = 8;

__host__ __device__ __forceinline__ int lds_byte(int r, int c) { const int st = (r >> 4) * 2 + (c >> 5), rr = r & 15, cc = c & 31, ob = rr * 64 + cc * 2; return st * 1024 + (ob ^ (((ob >> 9) & 1) << 5)); }
__host__ __device__ __forceinline__ void stage_rc(int b, int& R, int& C) { const int st = b / 1024, sb = b % 1024, swz = sb ^ (((sb >> 9) & 1) << 5); R = (st >> 1) * 16 + swz / 64; C = (st & 1) * 32 + (swz % 64) / 2; }
__host__ __device__ __forceinline__ int perm32(int rho) { const int n = rho >> 4, i = rho & 15; return 8 * (i >> 2) + 4 * n + (i & 3); }

struct Unit { int pm, pn; };
struct Gemm { const bf16_t* A; const bf16_t* Bt; int M, N, K; };

struct StaticOrder {
    int nM, nN, nwg, G, c;
    __host__ __device__ void init(int M, int N, int G_, int c_) { nM = M / BM; nN = N / BM; nwg = nM * nN; G = G_; c = c_; }
    __host__ __device__ bool next(int i, Unit& u) const {
        const long L = (long)i * G + c; if (L >= nwg) return false;
        int wgid = (int)L; { const int q = nwg / NXCD, r = nwg % NXCD, xcd = wgid % NXCD, off = wgid / NXCD; wgid = (xcd < r ? xcd * (q + 1) : r * (q + 1) + (xcd - r) * q) + off; }
        const int nig = WGM * nN, gid = wgid / nig, fm = gid * WGM, gsz = (nM - fm) < WGM ? (nM - fm) : WGM;
        u.pm = fm + ((wgid % nig) % gsz); u.pn = (wgid % nig) / gsz; return true;
    }
    __device__ __forceinline__ void a_ready(const Unit&) const {}
    __device__ __forceinline__ void done(const Unit&) const {}
};

__device__ __forceinline__ unsigned cvt_pk_bf16(float lo, float hi) { unsigned r; asm volatile("v_cvt_pk_bf16_f32 %0, %1, %2" : "=v"(r) : "v"(lo), "v"(hi)); return r; }
typedef float f32x2 __attribute__((ext_vector_type(2)));

typedef unsigned u32x4e __attribute__((ext_vector_type(4)));
__device__ __forceinline__ float bf_lo(unsigned w) { return __builtin_bit_cast(float, w << 16); }
__device__ __forceinline__ float bf_hi(unsigned w) { return __builtin_bit_cast(float, w & 0xffff0000u); }
__device__ __forceinline__ float sigmoidf_fast(float x) { return __builtin_amdgcn_rcpf(1.0f + __builtin_amdgcn_exp2f(-1.4426950408889634f * x)); }
constexpr int LDP = 10752;
constexpr int SEQ_ = 8192;
constexpr size_t R_FQ = 0, R_FK = (size_t)SEQ_ * 1024, R_FV = (size_t)2 * SEQ_ * 1024, R_SQ = (size_t)3 * SEQ_ * 1024, R_SK = (size_t)4 * SEQ_ * 1024, R_SV = R_SK + (size_t)SEQ_ * 256,
                 R_GF = R_SV + (size_t)SEQ_ * 256, R_GS = R_GF + (size_t)SEQ_ * 1024, R_MF = R_GS + (size_t)SEQ_ * 1024, R_MS = R_MF + (size_t)SEQ_ * 2048;
constexpr int C_FQ = 0, C_FK = 1024, C_FV = 2048, C_SQ = 3072, C_SK = 4096, C_SV = 4352, C_GF = 4608, C_GS = 5632, C_MF = 6656, C_MS = 8704;
constexpr float QS_FOX = 0.08838834764831845f * 1.4426950408889634f;
constexpr float QS_SWA = 0.125f * 1.4426950408889634f;

struct EpiProj {
    static constexpr bool PERM = true, AFTER_DRAIN = false;
    bf16_t* O;
    __device__ __forceinline__ void operator()(const f32x4 (&acc)[2][2][4][2], const Unit& u, int wr, int wc, int fr, int fq) const {
        const int pn = u.pn;
        int mode = 0; float sc = 1.f;
        size_t boff; int c0, rs, hsh;
        if (pn < 12) { const int t = pn >> 2; boff = (size_t)t * SEQ_ * 1024; c0 = t * 1024; rs = 128; hsh = 7; if (t == 0) sc = QS_FOX; }
        else if (pn < 16) { boff = (size_t)3 * SEQ_ * 1024; c0 = 3072; rs = 64; hsh = 6; sc = QS_SWA; }
        else if (pn < 18) { boff = (size_t)4 * SEQ_ * 1024 + (size_t)(pn - 16) * SEQ_ * 256; c0 = 4096 + (pn - 16) * 256; rs = 64; hsh = 6; }
        else if (pn < 26) { const int t = (pn - 18) >> 2; boff = (size_t)4 * SEQ_ * 1024 + (size_t)SEQ_ * 512 + (size_t)t * SEQ_ * 1024; c0 = 4608 + t * 1024; rs = 1024; hsh = 31; mode = 1; }
        else { const int t = (pn - 26) >> 3; boff = (size_t)6 * SEQ_ * 1024 + (size_t)SEQ_ * 512 + (size_t)t * SEQ_ * 2048; c0 = 6656 + t * 2048; rs = 2048; hsh = 31; mode = 2; }
        const int row0 = u.pm * BM + wr * 64 + fr; const int crel0 = pn * BM + wc * 32 + 8 * fq - c0;
#pragma unroll
        for (int bj = 0; bj < 2; ++bj) { const int crel = crel0 + bj * HALF;
            const int head = (hsh == 31) ? 0 : (crel >> hsh), d = (hsh == 31) ? crel : (crel & ((1 << hsh) - 1));
            bf16_t* colp = O + boff + (size_t)head * SEQ_ * rs + d;
#pragma unroll
            for (int ai = 0; ai < 2; ++ai)
#pragma unroll
                for (int m = 0; m < 4; ++m) { f32x4 v0 = acc[ai][bj][m][0], v1 = acc[ai][bj][m][1];
                    if (mode == 0) { v0 = v0 * sc; v1 = v1 * sc; }
                    else {
#pragma unroll
                        for (int e = 0; e < 4; ++e) { const float s0 = sigmoidf_fast(v0[e]), s1 = sigmoidf_fast(v1[e]); v0[e] = (mode == 1) ? v0[e] * s0 : s0; v1[e] = (mode == 1) ? v1[e] * s1 : s1; }
                    }
                    u32x4e w; w.x = cvt_pk_bf16(v0[0], v0[1]); w.y = cvt_pk_bf16(v0[2], v0[3]); w.z = cvt_pk_bf16(v1[0], v1[1]); w.w = cvt_pk_bf16(v1[2], v1[3]);
                    *(u32x4e*)(colp + (size_t)(row0 + ai * HALF + m * 16) * rs) = w; } }
    }
};
struct EpiPartial {
    static constexpr bool PERM = true, AFTER_DRAIN = false;
    float* part; const bf16_t* sig;
    __device__ __forceinline__ void operator()(const f32x4 (&acc)[2][2][4][2], const Unit& u, int wr, int wc, int fr, int fq) const {
        const int row0 = u.pm * BM + wr * 64 + fr; const int col0 = u.pn * BM + wc * 32 + 8 * fq;
#pragma unroll
        for (int ai = 0; ai < 2; ++ai)
#pragma unroll
            for (int m = 0; m < 4; ++m) { const size_t r = (size_t)(row0 + ai * HALF + m * 16);
#pragma unroll
                for (int bj = 0; bj < 2; ++bj) { const int c = col0 + bj * HALF;
                    const u32x4e s = *(const u32x4e*)(sig + r * 2048 + c);
                    f32x4 v0 = acc[ai][bj][m][0], v1 = acc[ai][bj][m][1];
                    v0[0] *= bf_lo(s.x); v0[1] *= bf_hi(s.x); v0[2] *= bf_lo(s.y); v0[3] *= bf_hi(s.y);
                    v1[0] *= bf_lo(s.z); v1[1] *= bf_hi(s.z); v1[2] *= bf_lo(s.w); v1[3] *= bf_hi(s.w);
                    float* p = part + r * 2048 + c; *(f32x4*)p = v0; *(f32x4*)(p + 4) = v1; }
                asm volatile("" ::: "memory"); }
    }
};
struct EpiMerge {
    static constexpr bool PERM = true, AFTER_DRAIN = false;
    const float* part; const bf16_t* sig; bf16_t* O;
    __device__ __forceinline__ void operator()(const f32x4 (&acc)[2][2][4][2], const Unit& u, int wr, int wc, int fr, int fq) const {
        const int row0 = u.pm * BM + wr * 64 + fr; const int col0 = u.pn * BM + wc * 32 + 8 * fq;
#pragma unroll
        for (int ai = 0; ai < 2; ++ai)
#pragma unroll
            for (int m = 0; m < 4; ++m) { const size_t r = (size_t)(row0 + ai * HALF + m * 16);
#pragma unroll
                for (int bj = 0; bj < 2; ++bj) { const int c = col0 + bj * HALF;
                    const u32x4e s = *(const u32x4e*)(sig + r * 2048 + c);
                    const float* p = part + r * 2048 + c; const f32x4 p0 = *(const f32x4*)p, p1 = *(const f32x4*)(p + 4);
                    f32x4 v0 = acc[ai][bj][m][0], v1 = acc[ai][bj][m][1];
                    v0[0] = p0[0] + v0[0] * bf_lo(s.x); v0[1] = p0[1] + v0[1] * bf_hi(s.x); v0[2] = p0[2] + v0[2] * bf_lo(s.y); v0[3] = p0[3] + v0[3] * bf_hi(s.y);
                    v1[0] = p1[0] + v1[0] * bf_lo(s.z); v1[1] = p1[1] + v1[1] * bf_hi(s.z); v1[2] = p1[2] + v1[2] * bf_lo(s.w); v1[3] = p1[3] + v1[3] * bf_hi(s.w);
                    u32x4e w; w.x = cvt_pk_bf16(v0[0], v0[1]); w.y = cvt_pk_bf16(v0[2], v0[3]); w.z = cvt_pk_bf16(v1[0], v1[1]); w.w = cvt_pk_bf16(v1[2], v1[3]);
                    *(u32x4e*)(O + r * 2048 + c) = w; }
                asm volatile("" ::: "memory"); }
    }
};
struct EpiZ {
    static constexpr bool PERM = true, AFTER_DRAIN = false;
    const float* x; const float* gate; float* z; float alpha;
    __device__ __forceinline__ void operator()(const f32x4 (&acc)[2][2][4][2], const Unit& u, int wr, int wc, int fr, int fq) const {
        const int row0 = u.pm * BM + wr * 64 + fr; const int col0 = u.pn * BM + wc * 32 + 8 * fq;
#pragma unroll
        for (int bj = 0; bj < 2; ++bj) { const int c = col0 + bj * HALF;
            const f32x4 g0 = *(const f32x4*)(gate + c), g1 = *(const f32x4*)(gate + c + 4);
#pragma unroll
            for (int ai = 0; ai < 2; ++ai)
#pragma unroll
                for (int m = 0; m < 4; ++m) { const size_t r = (size_t)(row0 + ai * HALF + m * 16);
                    const float* xp = x + r * 2048 + c; const f32x4 x0 = *(const f32x4*)xp, x1 = *(const f32x4*)(xp + 4);
                    const f32x4 v0 = x0 * alpha + g0 * acc[ai][bj][m][0], v1 = x1 * alpha + g1 * acc[ai][bj][m][1];
                    float* zp = z + r * 2048 + c; *(f32x4*)zp = v0; *(f32x4*)(zp + 4) = v1;
                    asm volatile("" ::: "memory"); } }
    }
};

template <class Epi, class Sched, bool ALIGN_EPI = false, bool SP2 = false>
__device__ __forceinline__ void gemm_phase(PG8_LAS unsigned char* lds, const Gemm g, const Sched& S, const Epi& E) {
    const int tid = threadIdx.x, wid = __builtin_amdgcn_readfirstlane(tid >> 6), lane = tid & 63, wr = wid >> 2, wc = wid & 3, fr = lane & 15, fq = lane >> 4;
    const int K = g.K, nt = K / BK;
    unsigned voffA[2], voffB[2];
#pragma unroll
    for (int i = 0; i < 2; ++i) { int R, C; stage_rc(tid * 16 + i * 8192, R, C); const int Rb = Epi::PERM ? ((R & ~31) + perm32(R & 31)) : R;
        voffA[i] = (unsigned)(R * K + C) * 2u; voffB[i] = (unsigned)(Rb * K + C) * 2u; }
    const size_t kstep = (size_t)(BK * 2);
    const size_t hstep = (size_t)HALF * K * 2;
    const size_t tstep = 2 * hstep;
    const unsigned ldsw = (unsigned)wid * 1024u;
    const int aoff = lds_byte(wr * 64 + fr, fq * 8), boff = lds_byte(wc * 32 + fr, fq * 8);
#define PG8_SA(b, h) (((b) * 2 + (h)) * HTB)
#define PG8_SB(b, h) ((4 + (b) * 2 + (h)) * HTB)
#define PG8_STAGE(bufoff, gbase, voff) do { _Pragma("unroll") for (int _i = 0; _i < 2; ++_i) \
        __builtin_amdgcn_global_load_lds((const unsigned*)((const char*)(gbase) + (voff)[_i]), (PG8_LAS unsigned*)(lds + (bufoff) + ldsw + _i * 8192), 16, 0, 0); } while (0)
#define PG8_LDA(dst, b, h) do { _Pragma("unroll") for (int m = 0; m < 4; ++m) _Pragma("unroll") for (int k = 0; k < 2; ++k) dst[m][k] = *(const PG8_LAS bf16x8*)(lds + PG8_SA(b, h) + aoff + m * 2048 + k * 1024); } while (0)
#define PG8_LDB(dst, b, h) do { _Pragma("unroll") for (int n = 0; n < 2; ++n) _Pragma("unroll") for (int k = 0; k < 2; ++k) dst[n][k] = *(const PG8_LAS bf16x8*)(lds + PG8_SB(b, h) + boff + n * 2048 + k * 1024); } while (0)
#define PG8_MMA(ai, bj, At, Bt) do { __builtin_amdgcn_s_setprio(1); _Pragma("unroll") for (int m = 0; m < 4; ++m) _Pragma("unroll") for (int n = 0; n < 2; ++n) _Pragma("unroll") for (int k = 0; k < 2; ++k) \
        acc[ai][bj][m][n] = __builtin_amdgcn_mfma_f32_16x16x32_bf16(Bt[n][k], At[m][k], acc[ai][bj][m][n], 0, 0, 0); __builtin_amdgcn_s_setprio(0); } while (0)
#define PG8_WAIT_V(n) asm volatile("s_waitcnt vmcnt(" #n ")" ::: "memory")
#define PG8_WAIT_L(n) asm volatile("s_waitcnt lgkmcnt(" #n ")" ::: "memory")
#define PG8_BAR __builtin_amdgcn_s_barrier()
#define PG8_SCHED __builtin_amdgcn_sched_barrier(0)
    Unit cur, nxt; int ui = 0;
    if (!S.next(0, cur)) return;
    f32x4 acc[2][2][4][2];
#pragma unroll
    for (int a = 0; a < 2; ++a)
#pragma unroll
        for (int b = 0; b < 2; ++b)
#pragma unroll
            for (int m = 0; m < 4; ++m)
#pragma unroll
                for (int n = 0; n < 2; ++n) acc[a][b][m][n] = (f32x4){0.f, 0.f, 0.f, 0.f};
    bf16x8 At[4][2], B0[2][2], B1[2][2];
    const char* cA = (const char*)g.A + (size_t)cur.pm * tstep; const char* cB = (const char*)g.Bt + (size_t)cur.pn * tstep;
    S.a_ready(cur);
    if constexpr (SP2) {
        PG8_STAGE(PG8_SB(0, 0), cB, voffB); PG8_STAGE(PG8_SB(0, 1), cB + hstep, voffB); PG8_STAGE(PG8_SA(0, 0), cA, voffA); PG8_STAGE(PG8_SA(0, 1), cA + hstep, voffA);
        if (wr == 1) PG8_BAR;
        PG8_WAIT_V(2); PG8_BAR;
        PG8_STAGE(PG8_SB(1, 0), cB + kstep, voffB); PG8_STAGE(PG8_SA(1, 0), cA + kstep, voffA); PG8_STAGE(PG8_SB(1, 1), cB + hstep + kstep, voffB);
        PG8_WAIT_V(6); PG8_BAR;
    } else {
        PG8_STAGE(PG8_SB(0, 0), cB, voffB); PG8_STAGE(PG8_SA(0, 0), cA, voffA); PG8_STAGE(PG8_SB(0, 1), cB + hstep, voffB); PG8_STAGE(PG8_SA(0, 1), cA + hstep, voffA);
        if (wr == 1) PG8_BAR;
        PG8_WAIT_V(4); PG8_BAR;
        PG8_STAGE(PG8_SB(1, 0), cB + kstep, voffB); PG8_STAGE(PG8_SA(1, 0), cA + kstep, voffA); PG8_STAGE(PG8_SB(1, 1), cB + hstep + kstep, voffB);
        PG8_WAIT_V(6); PG8_BAR;
    }
    for (;;) {
        const bool has_next = S.next(ui + 1, nxt);
        const char* nA = has_next ? (const char*)g.A + (size_t)nxt.pm * tstep : cA; const char* nB = has_next ? (const char*)g.Bt + (size_t)nxt.pn * tstep : cB;
        for (int t = 0; t < nt; t += 2) {
            const bool last = (t == nt - 2);
            const char* a1 = cA + (size_t)(t + 1) * kstep;
            const char* a2 = last ? nA : cA + (size_t)(t + 2) * kstep; const char* b2 = last ? nB : cB + (size_t)(t + 2) * kstep;
            const char* a3 = a2 + kstep; const char* b3 = b2 + kstep;
            if (last && has_next) S.a_ready(nxt);
            if constexpr (SP2) {
            PG8_LDB(B0, 0, 0); PG8_LDB(B1, 0, 1); PG8_SCHED; PG8_LDA(At, 0, 0); PG8_STAGE(PG8_SA(1, 1), a1 + hstep, voffA);
            PG8_WAIT_V(8); PG8_WAIT_L(0); PG8_BAR; PG8_MMA(0, 0, At, B0); PG8_MMA(0, 1, At, B1); PG8_BAR; PG8_SCHED;
            PG8_LDA(At, 0, 1); PG8_STAGE(PG8_SB(0, 0), b2, voffB); PG8_STAGE(PG8_SB(0, 1), b2 + hstep, voffB); PG8_STAGE(PG8_SA(0, 0), a2, voffA);
            PG8_WAIT_V(8); PG8_WAIT_L(0); PG8_BAR; PG8_MMA(1, 0, At, B0); PG8_MMA(1, 1, At, B1); PG8_BAR; PG8_SCHED;
            PG8_LDB(B0, 1, 0); PG8_LDB(B1, 1, 1); PG8_SCHED; PG8_LDA(At, 1, 0); PG8_STAGE(PG8_SA(0, 1), a2 + hstep, voffA);
            PG8_WAIT_V(8); PG8_WAIT_L(0); PG8_BAR; PG8_MMA(0, 0, At, B0); PG8_MMA(0, 1, At, B1); PG8_BAR; PG8_SCHED;
            PG8_LDA(At, 1, 1); PG8_STAGE(PG8_SB(1, 0), b3, voffB); PG8_STAGE(PG8_SB(1, 1), b3 + hstep, voffB); PG8_STAGE(PG8_SA(1, 0), a3, voffA);
            PG8_WAIT_V(8); PG8_WAIT_L(0); PG8_BAR; PG8_MMA(1, 0, At, B0); PG8_MMA(1, 1, At, B1); PG8_BAR; PG8_SCHED;
            } else {
            PG8_LDB(B0, 0, 0); PG8_SCHED; PG8_LDA(At, 0, 0); PG8_STAGE(PG8_SA(1, 1), a1 + hstep, voffA);
            PG8_WAIT_L(8); PG8_BAR; PG8_WAIT_L(0); PG8_MMA(0, 0, At, B0); PG8_BAR; PG8_SCHED;
            PG8_LDB(B1, 0, 1); PG8_STAGE(PG8_SB(0, 0), b2, voffB);
            PG8_BAR; PG8_WAIT_L(0); PG8_MMA(0, 1, At, B1); PG8_BAR;
            PG8_LDA(At, 0, 1); PG8_STAGE(PG8_SA(0, 0), a2, voffA);
            PG8_BAR; PG8_WAIT_L(0); PG8_MMA(1, 0, At, B0); PG8_BAR; PG8_SCHED;
            PG8_STAGE(PG8_SB(0, 1), b2 + hstep, voffB);
            PG8_WAIT_V(6); PG8_BAR; PG8_MMA(1, 1, At, B1); PG8_BAR;
            PG8_LDB(B0, 1, 0); PG8_SCHED; PG8_LDA(At, 1, 0); PG8_STAGE(PG8_SA(0, 1), a2 + hstep, voffA);
            PG8_WAIT_L(8); PG8_BAR; PG8_WAIT_L(0); PG8_MMA(0, 0, At, B0); PG8_BAR; PG8_SCHED;
            PG8_LDB(B1, 1, 1); PG8_STAGE(PG8_SB(1, 0), b3, voffB);
            PG8_BAR; PG8_WAIT_L(0); PG8_MMA(0, 1, At, B1); PG8_BAR;
            PG8_LDA(At, 1, 1); PG8_STAGE(PG8_SA(1, 0), a3, voffA);
            PG8_BAR; PG8_WAIT_L(0); PG8_MMA(1, 0, At, B0); PG8_BAR; PG8_SCHED;
            PG8_STAGE(PG8_SB(1, 1), b3 + hstep, voffB);
            PG8_WAIT_V(6); PG8_BAR; PG8_MMA(1, 1, At, B1); PG8_BAR;
            }
        }
        if constexpr (ALIGN_EPI) { if (wr == 0) PG8_BAR; }
        if constexpr (!Epi::AFTER_DRAIN) { E(acc, cur, wr, wc, fr, fq); S.done(cur); }
        if (!has_next) break;
#pragma unroll
        for (int a = 0; a < 2; ++a)
#pragma unroll
            for (int b = 0; b < 2; ++b)
#pragma unroll
                for (int m = 0; m < 4; ++m)
#pragma unroll
                    for (int n = 0; n < 2; ++n) acc[a][b][m][n] = (f32x4){0.f, 0.f, 0.f, 0.f};
        cur = nxt; cA = nA; cB = nB; ++ui;
        if constexpr (ALIGN_EPI) { if (wr == 1) PG8_BAR; }
    }
    PG8_WAIT_V(0);
    if constexpr (!ALIGN_EPI) { if (wr == 0) PG8_BAR; }
    PG8_BAR;
    if constexpr (Epi::AFTER_DRAIN) { E.fused(acc, cur, wr, wc, fr, fq, lds, wid, lane); S.done(cur); }
#undef PG8_SA
#undef PG8_SB
#undef PG8_STAGE
#undef PG8_LDA
#undef PG8_LDB
#undef PG8_MMA
#undef PG8_WAIT_V
#undef PG8_WAIT_L
#undef PG8_BAR
#undef PG8_SCHED
}
}

#define GAS __attribute__((address_space(1)))
#define LAS __attribute__((address_space(3)))
typedef unsigned short bf16;
typedef unsigned v4u __attribute__((ext_vector_type(4)));
typedef unsigned v2u __attribute__((ext_vector_type(2)));
typedef float f32x4 __attribute__((ext_vector_type(4)));
typedef short bf16x8 __attribute__((ext_vector_type(8)));
typedef float f32x16 __attribute__((ext_vector_type(16)));
#define LDS_WAIT() asm volatile("s_waitcnt lgkmcnt(0)" ::: "memory")

constexpr int SEQ = 8192, DM = 2048, NIN = 10760, NWAVES = 8, NTHREADS = 512;
constexpr int LDP = pg8::LDP;
constexpr float LN_EPS = 1e-5f;
constexpr float LOG2E = 1.4426950408889634f;
constexpr float DN_ALPHA = 1.189207115002721f;
constexpr float NEG_BIG = -1e30f;

constexpr size_t MiB = 1u << 20;
constexpr size_t WS_ADA = 0;
constexpr size_t WS_BAR = 32 * 1024, WS_BAR_BYTES = 16 * 1024;
constexpr size_t WS_LOGF = 64 * 1024;
constexpr size_t WS_CUM = WS_LOGF + 256 * 1024;
constexpr size_t WS_WIN_T = 1 * MiB;
constexpr size_t WS_WBF_T = 44 * MiB;
constexpr size_t WS_WBS_T = 48 * MiB;
constexpr size_t WS_WOUT_T = 52 * MiB;
constexpr size_t WS_H = 64 * MiB;
constexpr size_t WS_PROJ = 96 * MiB;
constexpr size_t WS_AF = 264 * MiB;
constexpr size_t WS_AS = 280 * MiB;
constexpr size_t WS_END = 296 * MiB;
constexpr size_t WS_SCR = 296 * MiB;

constexpr int LDS_BYTES = 147456, LDS_MISC_OFF = LDS_BYTES - 64;

__device__ __forceinline__ unsigned f2bf(float f) { unsigned u = __builtin_bit_cast(unsigned, f); return (u + 0x7fffu + ((u >> 16) & 1u)) >> 16; }
__device__ __forceinline__ unsigned pk2(float lo, float hi) { return f2bf(lo) | (f2bf(hi) << 16); }
__device__ __forceinline__ float bf2f(bf16 v) { return __builtin_bit_cast(float, (unsigned)v << 16); }
__device__ __forceinline__ float wave_sum(float v) {
#pragma unroll
    for (int o = 1; o < 64; o <<= 1) v += __shfl_xor(v, o);
    return v;
}
__device__ __forceinline__ float wave_max(float v) {
#pragma unroll
    for (int o = 1; o < 64; o <<= 1) v = fmaxf(v, __shfl_xor(v, o));
    return v;
}

struct Args { const float* in[12]; float* out; unsigned char* ws; int ph_lo, ph_hi, var, pad; };

__device__ __forceinline__ void p0_transpose_item(const float* W, int K, int ldw, int N, bf16* WT, LAS float* scr, int item, int lane) {
    const int nblk = N / 32, kb = item / nblk, nb = item % nblk, k0 = 64 * kb, n0 = 32 * nb;
#pragma unroll 8
    for (int i = 0; i < 32; ++i) { const int kk = 2 * i + (lane >> 5); scr[kk * 33 + (lane & 31)] = W[(size_t)(k0 + kk) * ldw + n0 + (lane & 31)]; }
    LDS_WAIT(); asm volatile("" ::: "memory");
    const int c = lane & 7;
#pragma unroll
    for (int j = 0; j < 4; ++j) { const int n = (lane >> 3) + 8 * j; const LAS float* s = scr + (8 * c) * 33 + n;
        v4u o; o.x = pk2(s[0 * 33], s[1 * 33]); o.y = pk2(s[2 * 33], s[3 * 33]); o.z = pk2(s[4 * 33], s[5 * 33]); o.w = pk2(s[6 * 33], s[7 * 33]);
        *(v4u*)(WT + (size_t)(n0 + n) * K + k0 + 8 * c) = o; }
    LDS_WAIT(); asm volatile("" ::: "memory");
}

__device__ __forceinline__ void phase0(const Args& a, LAS unsigned char* lds) {
    const int tid = threadIdx.x, lane = tid & 63, wave = tid >> 6, G = gridDim.x;
    const float* c = a.in[1]; const float* w_ada = a.in[2]; const float* b_ada = a.in[3];
    float* ada = (float*)(a.ws + WS_ADA);
    LAS float* red = (LAS float*)lds;
    for (int cb = blockIdx.x; cb < 256; cb += G) {
        const int c4 = tid % 6, ks = tid / 6;
        f32x4 acc = {0.f, 0.f, 0.f, 0.f};
        if (ks < 85) {
            for (int k = ks; k < DM; k += 85) { const f32x4 w = *(const f32x4*)(w_ada + (size_t)k * 6144 + 24 * cb + 4 * c4); acc += w * c[k]; }
            *(LAS f32x4*)(red + ks * 24 + 4 * c4) = acc;
        }
        __syncthreads();
        if (tid < 24) { float s = 0.f; for (int i = 0; i < 85; ++i) s += red[i * 24 + tid]; ada[24 * cb + tid] = s + b_ada[24 * cb + tid]; }
        __syncthreads();
    }
    LAS float* scr = (LAS float*)(lds + wave * 16384);
    const int gw = blockIdx.x * NWAVES + wave, NGW = G * NWAVES;
    const float* w_in = a.in[4];
    constexpr int I_A = (DM / 64) * (3072 / 32), I_B = (DM / 64) * (7680 / 32), I_F = (1024 / 64) * (DM / 32), I_O = (DM / 64) * (DM / 32);
    constexpr int NITEMS = I_A + I_B + 2 * I_F + I_O;
    bf16* win_t = (bf16*)(a.ws + WS_WIN_T);
    for (int it = gw; it < NITEMS; it += NGW) {
        int r = it;
        if (r < I_A) { p0_transpose_item(w_in, DM, NIN, 3072, win_t, scr, r, lane); continue; } r -= I_A;
        if (r < I_B) { p0_transpose_item(w_in + 3080, DM, NIN, 7680, win_t + (size_t)3072 * DM, scr, r, lane); continue; } r -= I_B;
        if (r < I_F) { p0_transpose_item(a.in[7], 1024, DM, DM, (bf16*)(a.ws + WS_WBF_T), scr, r, lane); continue; } r -= I_F;
        if (r < I_F) { p0_transpose_item(a.in[8], 1024, DM, DM, (bf16*)(a.ws + WS_WBS_T), scr, r, lane); continue; } r -= I_F;
        p0_transpose_item(a.in[9], DM, DM, DM, (bf16*)(a.ws + WS_WOUT_T), scr, r, lane);
    }
}

__device__ __forceinline__ void phase1(const Args& a, LAS unsigned char* lds) {
    const int tid = threadIdx.x, lane = tid & 63, wave = tid >> 6, G = gridDim.x;
    const float* x = a.in[0]; const float* w_in = a.in[4]; const float* b_f = a.in[5];
    const float* ada = (const float*)(a.ws + WS_ADA);
    bf16* H = (bf16*)(a.ws + WS_H);
    float* logf_ = (float*)(a.ws + WS_LOGF);
    LAS f32x4* w8 = (LAS f32x4*)lds;
    for (int i = tid; i < 4096; i += NTHREADS) { const int k = i >> 1, half = i & 1; const int l = (k >> 2) & 63, e = k & 3, j = k >> 8;
        w8[((half * 4 + e) * 8 + j) * 64 + l] = *(const f32x4*)(w_in + (size_t)k * NIN + 3072 + 4 * half); }
    __syncthreads();
    const int gw = blockIdx.x * NWAVES + wave, NGW = G * NWAVES;
    for (int m = gw; m < SEQ; m += NGW) {
        const f32x4* xr = (const f32x4*)(x + (size_t)m * DM) + lane;
        f32x4 v[8]; float s = 0.f;
#pragma unroll
        for (int j = 0; j < 8; ++j) { v[j] = xr[64 * j]; s += (v[j].x + v[j].y) + (v[j].z + v[j].w); }
        const float mean = wave_sum(s) * (1.f / DM); float s2 = 0.f;
#pragma unroll
        for (int j = 0; j < 8; ++j) { v[j] = v[j] - mean; s2 += (v[j].x * v[j].x + v[j].y * v[j].y) + (v[j].z * v[j].z + v[j].w * v[j].w); }
        const float rstd = 1.f / sqrtf(wave_sum(s2) * (1.f / DM) + LN_EPS);
        f32x4 al = {0.f, 0.f, 0.f, 0.f}, ah = {0.f, 0.f, 0.f, 0.f};
        v2u* o8 = (v2u*)(H + (size_t)m * DM) + lane;
#pragma unroll
        for (int j = 0; j < 8; ++j) {
            asm volatile("" ::: "memory");
            const f32x4 sh = *((const f32x4*)ada + lane + 64 * j), sc = *((const f32x4*)(ada + DM) + lane + 64 * j);
            const f32x4 hv = v[j] * rstd * (sc + 1.0f) + sh;
            v2u o; o.x = pk2(hv.x, hv.y); o.y = pk2(hv.z, hv.w); o8[64 * j] = o;
#pragma unroll
            for (int e = 0; e < 4; ++e) { const f32x4 wl = w8[((0 + e) * 8 + j) * 64 + lane], wh = w8[((4 + e) * 8 + j) * 64 + lane]; al += wl * hv[e]; ah += wh * hv[e]; }
        }
        float r8[8] = {al.x, al.y, al.z, al.w, ah.x, ah.y, ah.z, ah.w};
#pragma unroll
        for (int hh = 0; hh < 8; ++hh) r8[hh] = wave_sum(r8[hh]);
        if (lane < 8) { float t = r8[0];
#pragma unroll
            for (int hh = 1; hh < 8; ++hh) t = (lane == hh) ? r8[hh] : t;
            const float xx = t + b_f[lane];
            logf_[lane * SEQ + m] = fminf(xx, 0.f) - log1pf(expf(-fabsf(xx))); }
    }
}

__device__ __forceinline__ void scan_head(const Args& a, LAS unsigned char* lds, int h) {
    const int tid = threadIdx.x;
    const float* src = (const float*)(a.ws + WS_LOGF) + (size_t)h * SEQ + 16 * tid;
    float* dst = (float*)(a.ws + WS_CUM) + (size_t)h * SEQ + 16 * tid;
    LAS float* tot = (LAS float*)lds;
    float v[16];
#pragma unroll
    for (int i = 0; i < 4; ++i) { const f32x4 t = *((const f32x4*)src + i); v[4 * i] = t.x; v[4 * i + 1] = t.y; v[4 * i + 2] = t.z; v[4 * i + 3] = t.w; }
#pragma unroll
    for (int i = 1; i < 16; ++i) v[i] += v[i - 1];
    tot[tid] = v[15];
    __syncthreads();
    float base = 0.f;
    for (int i = 0; i < tid; ++i) base += tot[i];
#pragma unroll
    for (int i = 0; i < 4; ++i) { f32x4 t = {v[4 * i] + base, v[4 * i + 1] + base, v[4 * i + 2] + base, v[4 * i + 3] + base}; *((f32x4*)dst + i) = t; }
    __syncthreads();
}

template <bool FOX>
__device__ __forceinline__ void naive_attn(const Args& a, LAS unsigned char* lds) {
    constexpr int D = FOX ? 128 : 64, NH = FOX ? 8 : 16;
    const int tid = threadIdx.x, lane = tid & 63, wave = tid >> 6, G = gridDim.x;
    const bf16* P = (const bf16*)(a.ws + WS_PROJ);
    const float* cum = (const float*)(a.ws + WS_CUM);
    const float* sinks = a.in[6];
    bf16* O = (bf16*)(a.ws + (FOX ? WS_AF : WS_AS));
    LAS float* qs = (LAS float*)(lds + wave * 1024);
    LAS float* ps = qs + 128;
    const int gw = blockIdx.x * NWAVES + wave, NGW = G * NWAVES;
    for (int row = gw; row < SEQ * NH; row += NGW) {
        const int t = row / NH, h = row % NH;
        const bf16* Qr = P + (FOX ? pg8::R_FQ : pg8::R_SQ) + ((size_t)h * SEQ + t) * D;
        const bf16* Kb = P + (FOX ? pg8::R_FK + (size_t)h * SEQ * D : pg8::R_SK + (size_t)(h >> 2) * SEQ * D);
        const bf16* Vb = P + (FOX ? pg8::R_FV + (size_t)h * SEQ * D : pg8::R_SV + (size_t)(h >> 2) * SEQ * D);
        const bf16* Gr = P + (FOX ? pg8::R_GF : pg8::R_GS) + (size_t)t * 1024 + h * D;
        if (FOX) { qs[2 * lane] = bf2f(Qr[2 * lane]); qs[2 * lane + 1] = bf2f(Qr[2 * lane + 1]); }
        else qs[lane] = bf2f(Qr[lane]);
        LDS_WAIT();
        const float Ft = FOX ? cum[h * SEQ + t] : 0.f;
        const float slope2 = FOX ? 0.f : exp2f(-8.0f * (float)(h + 1) / 16.0f) * LOG2E;
        const int lo = FOX ? 0 : (t - 127 > 0 ? t - 127 : 0);
        float mrun = NEG_BIG, l = 0.f, o0 = 0.f, o1 = 0.f;
        for (int s0 = lo; s0 <= t; s0 += 64) {
            const int s = s0 + lane; const bool valid = s <= t;
            float xv = NEG_BIG;
            if (valid) { const bf16* kr = Kb + (size_t)s * D; float dot = 0.f;
                for (int d = 0; d < D; d += 8) { const v4u kk = *(const v4u*)(kr + d);
                    dot += qs[d] * pg8::bf_lo(kk.x) + qs[d + 1] * pg8::bf_hi(kk.x) + qs[d + 2] * pg8::bf_lo(kk.y) + qs[d + 3] * pg8::bf_hi(kk.y)
                         + qs[d + 4] * pg8::bf_lo(kk.z) + qs[d + 5] * pg8::bf_hi(kk.z) + qs[d + 6] * pg8::bf_lo(kk.w) + qs[d + 7] * pg8::bf_hi(kk.w); }
                xv = FOX ? dot + (Ft - cum[h * SEQ + s]) * LOG2E : dot - slope2 * (float)(t - s); }
            const float mx = wave_max(xv), mnew = fmaxf(mrun, mx), alpha = exp2f(mrun - mnew);
            const float p = valid ? exp2f(xv - mnew) : 0.f;
            l = l * alpha + wave_sum(p); o0 *= alpha; o1 *= alpha; mrun = mnew;
            ps[lane] = p; LDS_WAIT();
            const int nj = (t - s0 + 1) < 64 ? (t - s0 + 1) : 64;
            for (int j = 0; j < nj; ++j) { const float pj = ps[j]; const bf16* vr = Vb + (size_t)(s0 + j) * D;
                if (FOX) { const unsigned vv = *(const unsigned*)(vr + 2 * lane); o0 += pj * pg8::bf_lo(vv); o1 += pj * pg8::bf_hi(vv); }
                else o0 += pj * bf2f(vr[lane]); }
            LDS_WAIT();
        }
        if (!FOX) l += exp2f(sinks[h] * LOG2E - mrun);
        const float inv = 1.f / l;
        if (FOX) { const unsigned gg = *(const unsigned*)(Gr + 2 * lane);
            *(unsigned*)(O + (size_t)t * 1024 + h * D + 2 * lane) = pk2(o0 * inv * pg8::bf_lo(gg), o1 * inv * pg8::bf_hi(gg)); }
        else O[(size_t)t * 1024 + h * D + lane] = (bf16)f2bf(o0 * inv * bf2f(Gr[lane]));
    }
}

__device__ __forceinline__ void phase_ln_out(const Args& a) {
    const int tid = threadIdx.x, lane = tid & 63, wave = tid >> 6, G = gridDim.x;
    const float* lng = a.in[10]; const float* lnb = a.in[11];
    const int gw = blockIdx.x * NWAVES + wave, NGW = G * NWAVES;
    for (int m = gw; m < SEQ; m += NGW) {
        f32x4* zr = (f32x4*)(a.out + (size_t)m * DM) + lane;
        f32x4 v[8]; float s = 0.f;
#pragma unroll
        for (int j = 0; j < 8; ++j) { v[j] = zr[64 * j]; s += (v[j].x + v[j].y) + (v[j].z + v[j].w); }
        const float mean = wave_sum(s) * (1.f / DM); float s2 = 0.f;
#pragma unroll
        for (int j = 0; j < 8; ++j) { v[j] = v[j] - mean; s2 += (v[j].x * v[j].x + v[j].y * v[j].y) + (v[j].z * v[j].z + v[j].w * v[j].w); }
        const float rstd = 1.f / sqrtf(wave_sum(s2) * (1.f / DM) + LN_EPS);
#pragma unroll
        for (int j = 0; j < 8; ++j) { const f32x4 g = *((const f32x4*)lng + lane + 64 * j), b = *((const f32x4*)lnb + lane + 64 * j); zr[64 * j] = v[j] * rstd * g + b; }
    }
}

#define XB_TMO      128
#define XB_XCNT(j)  (256  + 64 * (j))
#define XB_XSUB(j)  (1280 + 64 * (j))
#define XB_XGEN(j)  (2304 + 64 * (j))
#define XB_TOP      3328
#define XB_TOPGEN   3392
#define XCD_BAR_WORDS 3456
#define XB_SPIN_CAP (1u << 18)

__device__ __forceinline__ unsigned xb_ld(unsigned* p)              { return __hip_atomic_load(p, __ATOMIC_RELAXED, __HIP_MEMORY_SCOPE_AGENT); }
__device__ __forceinline__ unsigned xb_add(unsigned* p, unsigned v) { return __hip_atomic_fetch_add(p, v, __ATOMIC_RELAXED, __HIP_MEMORY_SCOPE_AGENT); }
__device__ __forceinline__ unsigned xb_xcc_id() { return (unsigned)__builtin_amdgcn_s_getreg((3 << 11) | 20) & 0xFu; }
#define XB_SPIN(cond, bar) do { unsigned _sp = 0; while (cond) { __builtin_amdgcn_s_sleep(1); \
    if ((++_sp & 255u) == 0u) { if (xb_ld(&(bar)[XB_TMO])) break; if (_sp > XB_SPIN_CAP) { atomicAdd(&(bar)[XB_TMO], 1u); break; } } } } while (0)

struct XcdBarrier {
    unsigned* bar; unsigned x;
    volatile LAS unsigned* st;
};

__device__ __forceinline__ XcdBarrier xcd_barrier_post(unsigned* bar, volatile LAS unsigned* st) {
    XcdBarrier b; b.bar = bar; b.x = xb_xcc_id(); b.st = st;
    if (threadIdx.x == 0) (void)xb_add(&bar[XB_XCNT(b.x)], 1u);
    return b;
}
__device__ __forceinline__ void xcd_barrier_complete(unsigned* bar, unsigned x, unsigned& nloc, unsigned& nx) {
    const unsigned G = gridDim.x * gridDim.y * gridDim.z;
    unsigned sum, cnt, mine, sp = 0u;
    for (;;) {
        sum = 0u; cnt = 0u; mine = 0u;
#pragma unroll
        for (unsigned j = 0; j < 16; ++j) { const unsigned c = xb_ld(&bar[XB_XCNT(j)]); sum += c; cnt += (c > 0u) ? 1u : 0u; mine = (j == x) ? c : mine; }
        if (sum == G) break;
        __builtin_amdgcn_s_sleep(1);
        if ((++sp & 255u) == 0u) { if (xb_ld(&bar[XB_TMO])) break; if (sp > XB_SPIN_CAP) { atomicAdd(&bar[XB_TMO], 1u); break; } }
    }
    nloc = mine > 0u ? mine : 1u; nx = cnt > 0u ? cnt : 1u;
}

__device__ __forceinline__ void xcd_barrier(const XcdBarrier& b) {
    asm volatile("s_waitcnt vmcnt(0)" ::: "memory");
    __syncthreads();
    if (threadIdx.x == 0) {
        unsigned* bar = b.bar;
        __builtin_amdgcn_s_waitcnt(0);
        unsigned nloc = b.st[0], nx = b.st[1];
        if (nloc == 0u) { xcd_barrier_complete(bar, b.x, nloc, nx); b.st[0] = nloc; b.st[1] = nx; }
        const unsigned old = xb_add(&bar[XB_XSUB(b.x)], 1u);
        const unsigned gen = old / nloc;
        if (old + 1u == (gen + 1u) * nloc) {
            __builtin_amdgcn_fence(__ATOMIC_RELEASE, "agent");
            asm volatile("s_waitcnt vmcnt(0)" ::: "memory");
            const unsigned og = xb_add(&bar[XB_TOP], 1u);
            const unsigned tg = og / nx;
            if (og + 1u == (tg + 1u) * nx) xb_add(&bar[XB_TOPGEN], 1u);
            else XB_SPIN(xb_ld(&bar[XB_TOPGEN]) == tg, bar);
            __builtin_amdgcn_fence(__ATOMIC_ACQUIRE, "agent");
            xb_add(&bar[XB_XGEN(b.x)], 1u);
            asm volatile("s_waitcnt vmcnt(0)" ::: "memory");
        } else {
            XB_SPIN(xb_ld(&bar[XB_XGEN(b.x)]) == gen, bar);
            __builtin_amdgcn_fence(__ATOMIC_ACQUIRE, "agent");
            asm volatile("s_waitcnt vmcnt(0)" ::: "memory");
        }
    }
    __syncthreads();
}


typedef short s16x4 __attribute__((ext_vector_type(4)));
typedef short v4i16_t __attribute__((ext_vector_type(4)));
typedef float f32x2_t __attribute__((ext_vector_type(2)));
typedef __bf16 bf16x2_t __attribute__((ext_vector_type(2)));
#define MFMA32(a, b, c) __builtin_amdgcn_mfma_f32_32x32x16_bf16((a), (b), (c), 0, 0, 0)
__device__ __forceinline__ s16x4 vtr(LAS const unsigned char* p) { return __builtin_bit_cast(s16x4, __builtin_amdgcn_ds_read_tr16_b64_v4i16((LAS v4i16_t*)p)); }
__device__ __forceinline__ unsigned cvtpk(float lo, float hi) { f32x2_t v = {lo, hi}; bf16x2_t b = __builtin_convertvector(v, bf16x2_t); return __builtin_bit_cast(unsigned, b); }
__device__ __forceinline__ float xor32_max(float v) { auto rr = __builtin_amdgcn_permlane32_swap(__float_as_uint(v), __float_as_uint(v), false, false); return fmaxf(__uint_as_float(rr[0]), __uint_as_float(rr[1])); }
__device__ __forceinline__ float xor32_sum(float v) { auto rr = __builtin_amdgcn_permlane32_swap(__float_as_uint(v), __float_as_uint(v), false, false); return __uint_as_float(rr[0]) + __uint_as_float(rr[1]); }
__device__ __forceinline__ int crow(int i, int h) { return (i & 3) + 8 * (i >> 2) + 4 * h; }

template <bool FOX> struct AC {
    static constexpr int D = FOX ? 128 : 64, NDS = D / 16, NDB = D / 32;
    static constexpr int ROWB = D * 2;
    static constexpr int OFF_K = 0, OFF_V = 128 * ROWB, OFF_B = 2 * 128 * ROWB, BUF = OFF_B + 512;
    static constexpr int CPR = D / 8;
    static constexpr int NP = (128 * CPR / 64) / NWAVES;
    static constexpr int W = FOX ? (1 << 30) : 128;
    __device__ static __forceinline__ int swzK(int row) { return FOX ? (row & 15) : ((row >> 1) & 7); }
    __device__ static __forceinline__ int swzV(int row) { return FOX ? (row & 3) : ((row >> 1) & 1); }
};
__device__ __forceinline__ void glds16(const void* gsrc, unsigned lds_dst) { unsigned keep;
    asm volatile("s_mov_b32 %0, m0\n\ts_mov_b32 m0, %2\n\ts_nop 0\n\tglobal_load_lds_dwordx4 %1, off\n\ts_mov_b32 m0, %0" : "=&s"(keep) : "v"(gsrc), "s"(lds_dst) : "memory"); }
#define WAIT_ALL_BAR() asm volatile("s_waitcnt vmcnt(0) lgkmcnt(0)\n\ts_barrier" ::: "memory")
template <bool FOX>
__device__ __forceinline__ void dma_step(const bf16* Pk, const bf16* Pv, int key0, unsigned ldsbuf, int wave, int lane) {
    typedef AC<FOX> C;
#pragma unroll
    for (int i = 0; i < C::NP; ++i) { const int piece = wave * C::NP + i, L = piece * 64 + lane, row = L / C::CPR, cp = L % C::CPR;
        const int kc = cp ^ C::swzK(row), vc = ((((cp >> 2) ^ C::swzV(row)) << 2) | (cp & 3));
        const size_t ro = (size_t)(key0 + row) * C::D;
        glds16(Pk + ro + kc * 8, (unsigned)__builtin_amdgcn_readfirstlane(ldsbuf + C::OFF_K + piece * 1024));
        glds16(Pv + ro + vc * 8, (unsigned)__builtin_amdgcn_readfirstlane(ldsbuf + C::OFF_V + piece * 1024)); }
}

template <bool FOX>
__device__ __forceinline__ bool attn_tileA(LAS const unsigned char* Kb, LAS const float* Bb,
                                           const bf16x8 (&qf)[AC<FOX>::NDS], f32x16 (&oT)[AC<FOX>::NDB], float& m, float& l, bf16x8 (&pf)[2][2],
                                           int ka, int ta, int lane, float slope2) {
    typedef AC<FOX> C;
    const int dmax = ta + 31 - ka, dmin = ta - ka - 63;
    if (dmax < 0 || dmin >= C::W) return false;
    const bool need_mask = (dmin < 0) || (dmax >= C::W);
    const int r = lane & 31, h = lane >> 5;
    f32x16 s0, s1;
    if (FOX) {
#pragma unroll
        for (int g4 = 0; g4 < 4; ++g4) { const f32x4 b0 = *(LAS const f32x4*)(Bb + 8 * g4 + 4 * h), b1 = *(LAS const f32x4*)(Bb + 32 + 8 * g4 + 4 * h);
#pragma unroll
            for (int e = 0; e < 4; ++e) { s0[4 * g4 + e] = b0[e]; s1[4 * g4 + e] = b1[e]; } }
    } else {
#pragma unroll
        for (int i = 0; i < 16; ++i) { s0[i] = 0.f; s1[i] = 0.f; }
    }
    LAS const unsigned char* kp = Kb + r * C::ROWB; const int kx = (h ^ C::swzK(r)) * 16;
#pragma unroll
    for (int ds = 0; ds < C::NDS; ++ds) {
        const bf16x8 k0 = *(LAS const bf16x8*)(kp + (kx ^ (ds * 32))), k1 = *(LAS const bf16x8*)(kp + 32 * C::ROWB + (kx ^ (ds * 32)));
        s0 = MFMA32(k0, qf[ds], s0); s1 = MFMA32(k1, qf[ds], s1);
    }
    const int tl = ta + r - ka;
    if (!FOX) {
#pragma unroll
        for (int i = 0; i < 16; ++i) { const float d0 = (float)(tl - crow(i, h)); s0[i] -= slope2 * d0; s1[i] -= slope2 * (d0 - 32.f); }
    }
    if (need_mask) {
#pragma unroll
        for (int i = 0; i < 16; ++i) { const int d0 = tl - crow(i, h), d1 = d0 - 32;
            if (d0 < 0 || d0 >= C::W) s0[i] = -1e30f;
            if (d1 < 0 || d1 >= C::W) s1[i] = -1e30f; }
    }
    float mx = fmaxf(s0[0], s1[0]);
#pragma unroll
    for (int i = 1; i < 16; ++i) mx = fmaxf(mx, fmaxf(s0[i], s1[i]));
    mx = xor32_max(mx);
    const float mnew = fmaxf(m, mx), alpha = __builtin_amdgcn_exp2f(m - mnew);
    m = mnew;
    float ps = 0.f;
#pragma unroll
    for (int i = 0; i < 16; ++i) { s0[i] = __builtin_amdgcn_exp2f(s0[i] - mnew); s1[i] = __builtin_amdgcn_exp2f(s1[i] - mnew); ps += s0[i] + s1[i]; }
    l = l * alpha + ps;
#pragma unroll
    for (int db = 0; db < C::NDB; ++db) oT[db] = oT[db] * alpha;
#pragma unroll
    for (int s = 0; s < 2; ++s) {
        v4u a, b;
        a.x = cvtpk(s0[8 * s], s0[8 * s + 1]); a.y = cvtpk(s0[8 * s + 2], s0[8 * s + 3]); a.z = cvtpk(s0[8 * s + 4], s0[8 * s + 5]); a.w = cvtpk(s0[8 * s + 6], s0[8 * s + 7]);
        b.x = cvtpk(s1[8 * s], s1[8 * s + 1]); b.y = cvtpk(s1[8 * s + 2], s1[8 * s + 3]); b.z = cvtpk(s1[8 * s + 4], s1[8 * s + 5]); b.w = cvtpk(s1[8 * s + 6], s1[8 * s + 7]);
        pf[0][s] = __builtin_bit_cast(bf16x8, a); pf[1][s] = __builtin_bit_cast(bf16x8, b);
    }
    return true;
}
template <bool FOX>
__device__ __forceinline__ void attn_tileB(LAS const unsigned char* Vb, f32x16 (&oT)[AC<FOX>::NDB], const bf16x8 (&pf)[2][2], int lane) {
    typedef AC<FOX> C;
    const int h = lane >> 5;
    const int i16 = lane & 15, qq = i16 >> 2, pp = i16 & 3, blk = (lane >> 4) & 1;
    const int l0 = (4 * h + qq) * C::ROWB + C::swzV(qq) * 64 + 32 * blk + 8 * pp;
#pragma unroll
    for (int db = 0; db < C::NDB; ++db) {
        LAS const unsigned char* vp = Vb + (l0 ^ (db * 64));
#pragma unroll
        for (int b = 0; b < 2; ++b)
#pragma unroll
            for (int s = 0; s < 2; ++s) {
                const s16x4 lo = vtr(vp + (32 * b + 16 * s) * C::ROWB), hi = vtr(vp + (32 * b + 16 * s + 8) * C::ROWB);
                const bf16x8 va = __builtin_shufflevector(lo, hi, 0, 1, 2, 3, 4, 5, 6, 7);
                oT[db] = MFMA32(va, pf[b][s], oT[db]);
            }
    }
}

__device__ __forceinline__ void fox_unit(const Args& a, LAS unsigned char* lds, int hd, int qb) {
    typedef AC<true> C;
    const int tid = threadIdx.x, lane = tid & 63, wave = __builtin_amdgcn_readfirstlane(tid >> 6), rg = wave & 3, g = wave >> 2;
    const int r = lane & 31, hh = lane >> 5;
    const bf16* P = (const bf16*)(a.ws + WS_PROJ);
    const bf16* Pq = P + pg8::R_FQ + (size_t)hd * SEQ * 128; const bf16* Pk = P + pg8::R_FK + (size_t)hd * SEQ * 128; const bf16* Pv = P + pg8::R_FV + (size_t)hd * SEQ * 128; const bf16* Pg = P + pg8::R_GF + hd * 128;
    const float* cumh = (const float*)(a.ws + WS_CUM) + (size_t)hd * SEQ;
    bf16* O = (bf16*)(a.ws + WS_AF);
    const int q0 = 128 * qb, tq = q0 + 32 * rg + r;
    bf16x8 qf[C::NDS];
#pragma unroll
    for (int ds = 0; ds < C::NDS; ++ds) qf[ds] = *(const bf16x8*)(Pq + (size_t)tq * C::D + ds * 16 + hh * 8);
    const float Fq0 = cumh[q0];
    f32x16 oT[C::NDB];
#pragma unroll
    for (int db = 0; db < C::NDB; ++db)
#pragma unroll
        for (int i = 0; i < 16; ++i) oT[db][i] = 0.f;
    float m = -1e20f, l = 0.f;
    const unsigned lds0 = (unsigned)(uintptr_t)lds;
    float breg = 0.f;
    dma_step<true>(Pk, Pv, 0, lds0, wave, lane);
    if (tid < 128) { breg = cumh[tid]; ((LAS float*)(lds + C::OFF_B))[tid] = (Fq0 - breg) * LOG2E; }
    WAIT_ALL_BAR();
#pragma unroll
    for (int ds = 0; ds < C::NDS; ++ds) asm volatile("" : "+v"(qf[ds]));
    for (int s = 0; s <= qb; ++s) {
        const int cur = (s & 1) * C::BUF, nxt = C::BUF - cur;
        { const int nk = 128 * (s + 1) < SEQ - 128 ? 128 * (s + 1) : SEQ - 128; breg = cumh[nk + (tid & 127)]; }
        if (s < qb) dma_step<true>(Pk, Pv, 128 * (s + 1), lds0 + nxt, wave, lane);
        bf16x8 pf[2][2];
        if (attn_tileA<true>(lds + cur + C::OFF_K + 64 * g * C::ROWB, (LAS const float*)(lds + cur + C::OFF_B) + 64 * g, qf, oT, m, l, pf, 128 * s + 64 * g, q0 + 32 * rg, lane, 0.f))
            attn_tileB<true>(lds + cur + C::OFF_V + 64 * g * C::ROWB, oT, pf, lane);
        const float bval = (Fq0 - breg) * LOG2E; asm volatile("" :: "v"(bval));
        if (s < qb && tid < 128) ((LAS float*)(lds + nxt + C::OFF_B))[tid] = bval;
        WAIT_ALL_BAR();
    }
    LAS float* mg = (LAS float*)lds + rg * (66 * 64) + lane;
    if (g == 1) {
#pragma unroll
        for (int db = 0; db < C::NDB; ++db)
#pragma unroll
            for (int i = 0; i < 16; ++i) mg[(db * 16 + i) * 64] = oT[db][i];
        mg[64 * 64] = m; mg[65 * 64] = l;
    }
    __syncthreads();
    if (g == 0) {
        const float m1 = mg[64 * 64], l1 = mg[65 * 64], mt = fmaxf(m, m1), a0 = __builtin_amdgcn_exp2f(m - mt), a1 = __builtin_amdgcn_exp2f(m1 - mt);
        const float inv = 1.0f / xor32_sum(a0 * l + a1 * l1);
        const float s0 = a0 * inv, s1 = a1 * inv;
#pragma unroll
        for (int db = 0; db < C::NDB; ++db)
#pragma unroll
            for (int g4 = 0; g4 < 4; ++g4) { const int d = 32 * db + 8 * g4 + 4 * hh;
                asm volatile("" ::: "memory");
                const v2u gg = *(const v2u*)(Pg + (size_t)tq * 1024 + d);
                const float o0 = (s0 * oT[db][4 * g4] + s1 * mg[(db * 16 + 4 * g4) * 64]) * pg8::bf_lo(gg.x), o1 = (s0 * oT[db][4 * g4 + 1] + s1 * mg[(db * 16 + 4 * g4 + 1) * 64]) * pg8::bf_hi(gg.x);
                const float o2 = (s0 * oT[db][4 * g4 + 2] + s1 * mg[(db * 16 + 4 * g4 + 2) * 64]) * pg8::bf_lo(gg.y), o3 = (s0 * oT[db][4 * g4 + 3] + s1 * mg[(db * 16 + 4 * g4 + 3) * 64]) * pg8::bf_hi(gg.y);
                v2u w; w.x = cvtpk(o0, o1); w.y = cvtpk(o2, o3);
                *(v2u*)(O + (size_t)tq * 1024 + hd * 128 + d) = w; }
    }
    __syncthreads();
}

__device__ __forceinline__ void swa_unit(const Args& a, LAS unsigned char* lds, int nb, int hp) {
    typedef AC<false> C;
    const int tid = threadIdx.x, lane = tid & 63, wave = __builtin_amdgcn_readfirstlane(tid >> 6), rg = wave & 3, g = wave >> 2;
    const int r = lane & 31, hh = lane >> 5;
    const int head = 2 * hp + g, kvh = hp >> 1;
    const bf16* P = (const bf16*)(a.ws + WS_PROJ);
    const bf16* Pq = P + pg8::R_SQ + (size_t)head * SEQ * 64; const bf16* Pk = P + pg8::R_SK + (size_t)kvh * SEQ * 64; const bf16* Pv = P + pg8::R_SV + (size_t)kvh * SEQ * 64; const bf16* Pg = P + pg8::R_GS + head * 64;
    bf16* O = (bf16*)(a.ws + WS_AS);
    const int q0 = 128 * nb, tq = q0 + 32 * rg + r;
    const float slope2 = exp2f(-8.0f * (float)(head + 1) / 16.0f) * LOG2E;
    bf16x8 qf[C::NDS];
#pragma unroll
    for (int ds = 0; ds < C::NDS; ++ds) qf[ds] = *(const bf16x8*)(Pq + (size_t)tq * C::D + ds * 16 + hh * 8);
    f32x16 oT[C::NDB];
#pragma unroll
    for (int db = 0; db < C::NDB; ++db)
#pragma unroll
        for (int i = 0; i < 16; ++i) oT[db][i] = 0.f;
    float m = -1e20f, l = 0.f;
    const unsigned lds0 = (unsigned)(uintptr_t)lds;
    const int sfirst = nb > 0 ? nb - 1 : 0;
    dma_step<false>(Pk, Pv, 128 * sfirst, lds0, wave, lane);
    WAIT_ALL_BAR();
#pragma unroll
    for (int ds = 0; ds < C::NDS; ++ds) asm volatile("" : "+v"(qf[ds]));
    for (int s = sfirst; s <= nb; ++s) {
        const int cur = ((s - sfirst) & 1) * C::BUF, nxt = C::BUF - cur;
        if (s < nb) dma_step<false>(Pk, Pv, 128 * (s + 1), lds0 + nxt, wave, lane);
#pragma unroll 1
        for (int jt = 0; jt < 2; ++jt)
        { bf16x8 pf[2][2];
            if (attn_tileA<false>(lds + cur + C::OFF_K + 64 * jt * C::ROWB, nullptr, qf, oT, m, l, pf, 128 * s + 64 * jt, q0 + 32 * rg, lane, slope2))
                attn_tileB<false>(lds + cur + C::OFF_V + 64 * jt * C::ROWB, oT, pf, lane); }
        WAIT_ALL_BAR();
    }
    const float inv = 1.0f / (xor32_sum(l) + __builtin_amdgcn_exp2f(a.in[6][head] * LOG2E - m));
#pragma unroll
    for (int db = 0; db < C::NDB; ++db)
#pragma unroll
        for (int g4 = 0; g4 < 4; ++g4) { const int d = 32 * db + 8 * g4 + 4 * hh;
            const v2u gg = *(const v2u*)(Pg + (size_t)tq * 1024 + d);
            const float o0 = oT[db][4 * g4] * inv * pg8::bf_lo(gg.x), o1 = oT[db][4 * g4 + 1] * inv * pg8::bf_hi(gg.x), o2 = oT[db][4 * g4 + 2] * inv * pg8::bf_lo(gg.y), o3 = oT[db][4 * g4 + 3] * inv * pg8::bf_hi(gg.y);
            v2u w; w.x = cvtpk(o0, o1); w.y = cvtpk(o2, o3);
            *(v2u*)(O + (size_t)tq * 1024 + head * 64 + d) = w; }
}

#ifndef ATTN_FOX_FAST
#define ATTN_FOX_FAST 1
#endif
#ifndef ATTN_SWA_FAST
#define ATTN_SWA_FAST 1
#endif
__device__ __forceinline__ void phase_attn(const Args& a, LAS unsigned char* lds) {
    const int G = gridDim.x;
#if ATTN_FOX_FAST
    for (int p = blockIdx.x; p < 256; p += G) { const int hd = p & 7, j = p >> 3;
#pragma unroll 1
        for (int k = 0; k < 2; ++k) fox_unit(a, lds, hd, k ? j : 63 - j); }
#else
    naive_attn<true>(a, lds);
#endif
    __syncthreads();
#if ATTN_SWA_FAST
    for (int u = blockIdx.x; u < 512; u += G) { const int hp = u & 7, nb = u >> 3; swa_unit(a, lds, nb, hp); }
#else
    naive_attn<false>(a, lds);
#endif
}

constexpr int N_PHASES = 7;
__global__ void __launch_bounds__(NTHREADS) fwd_megakernel(Args args) {
    extern __shared__ __attribute__((aligned(16))) unsigned char lds_raw[];
    LAS unsigned char* lds = (LAS unsigned char*)lds_raw;
    cg::grid_group grid = cg::this_grid();
    const int lo = args.ph_lo, hi = args.ph_hi;
    const bool one = (lo == 0 && hi == N_PHASES);
    unsigned char* ws = args.ws;
    volatile LAS unsigned* misc = (volatile LAS unsigned*)(lds + LDS_MISC_OFF);
    if (threadIdx.x < 16) misc[threadIdx.x] = 0u;
    __syncthreads();
    XcdBarrier bar; bar.bar = (unsigned*)(ws + WS_BAR); bar.x = 0; bar.st = misc;
    if (one) bar = xcd_barrier_post((unsigned*)(ws + WS_BAR), misc);
#define IN(k) (lo <= (k) && (k) < hi)
#define SEAM_CG() do { if (one) grid.sync(); } while (0)
#define SEAM() do { if (one) xcd_barrier(bar); } while (0)
    SEAM_CG();
    if (IN(0)) { phase0(args, lds); SEAM(); }
    if (IN(1)) { phase1(args, lds); SEAM(); }
    if (IN(2)) {
        if (blockIdx.x < 8) scan_head(args, lds, blockIdx.x);
        pg8::Gemm g{(const pg8::bf16_t*)(ws + WS_H), (const pg8::bf16_t*)(ws + WS_WIN_T), SEQ, LDP, DM};
        pg8::StaticOrder S; S.init(SEQ, LDP, gridDim.x, (int)blockIdx.x);
        pg8::EpiProj E{(pg8::bf16_t*)(ws + WS_PROJ)};
        pg8::gemm_phase<pg8::EpiProj, pg8::StaticOrder, true, true>(lds, g, S, E);
        SEAM();
    }
    if (IN(3)) { phase_attn(args, lds); SEAM(); }
    if (IN(4)) {
        pg8::StaticOrder S; S.init(SEQ, DM, gridDim.x, (int)blockIdx.x);
        { pg8::Gemm g{(const pg8::bf16_t*)(ws + WS_AF), (const pg8::bf16_t*)(ws + WS_WBF_T), SEQ, DM, 1024};
          pg8::EpiPartial E{args.out, (const pg8::bf16_t*)(ws + WS_PROJ) + pg8::R_MF};
          pg8::gemm_phase<pg8::EpiPartial, pg8::StaticOrder, true, true>(lds, g, S, E); }
        __syncthreads();
        { pg8::Gemm g{(const pg8::bf16_t*)(ws + WS_AS), (const pg8::bf16_t*)(ws + WS_WBS_T), SEQ, DM, 1024};
          pg8::EpiMerge E{args.out, (const pg8::bf16_t*)(ws + WS_PROJ) + pg8::R_MS, (pg8::bf16_t*)(ws + WS_H)};
          pg8::gemm_phase<pg8::EpiMerge, pg8::StaticOrder, true, true>(lds, g, S, E); }
        SEAM();
    }
    if (IN(5)) {
        pg8::StaticOrder S; S.init(SEQ, DM, gridDim.x, (int)blockIdx.x);
        pg8::Gemm g{(const pg8::bf16_t*)(ws + WS_H), (const pg8::bf16_t*)(ws + WS_WOUT_T), SEQ, DM, DM};
        pg8::EpiZ E{args.in[0], (const float*)(ws + WS_ADA) + 2 * DM, args.out, DN_ALPHA};
        pg8::gemm_phase<pg8::EpiZ, pg8::StaticOrder, true, true>(lds, g, S, E);
        SEAM();
    }
    if (IN(6)) { phase_ln_out(args); }
#undef IN
#undef SEAM
#undef SEAM_CG
}

#ifndef MK_N_LAUNCHES
#define MK_N_LAUNCHES 1
#endif
extern "C" void kernel_launch(void* const* d_in, const int* in_sizes, int n_in, void* d_out, int out_size, void* d_ws, size_t ws_size, hipStream_t stream) {
    static int grid = 0;
    if (grid == 0) {
        if (n_in != 12 || out_size != SEQ * DM || ws_size < WS_END) { fprintf(stderr, "kernel_launch: unexpected shapes (n_in %d out %d ws %zu)\n", n_in, out_size, ws_size); grid = -1; return; }
        int dev = 0, cus = 0, per_cu = 0;
        hipGetDevice(&dev);
        hipDeviceGetAttribute(&cus, hipDeviceAttributeMultiprocessorCount, dev);
        if (hipFuncSetAttribute((const void*)fwd_megakernel, hipFuncAttributeMaxDynamicSharedMemorySize, LDS_BYTES) != hipSuccess) { fprintf(stderr, "kernel_launch: hipFuncSetAttribute failed\n"); grid = -1; return; }
        if (hipOccupancyMaxActiveBlocksPerMultiprocessor(&per_cu, (const void*)fwd_megakernel, NTHREADS, LDS_BYTES) != hipSuccess || per_cu < 1) { fprintf(stderr, "kernel_launch: occupancy query says %d\n", per_cu); per_cu = 1; }
        (void)hipGetLastError();
        grid = cus * (per_cu > 1 ? 1 : per_cu);
        fprintf(stderr, "kernel_launch: grid %d (cus %d per_cu %d)\n", grid, cus, per_cu);
    }
    if (grid < 0) return;
    Args a{};
    for (int i = 0; i < 12; ++i) a.in[i] = (const float*)d_in[i];
    a.out = (float*)d_out; a.ws = (unsigned char*)d_ws;
#if MK_N_LAUNCHES == 1
    if (hipMemsetAsync((char*)d_ws + WS_BAR, 0, WS_BAR_BYTES, stream) != hipSuccess) { fprintf(stderr, "kernel_launch: memset failed\n"); return; }
    a.ph_lo = 0; a.ph_hi = N_PHASES;
    void* kargs[] = {&a};
    hipError_t e = hipLaunchCooperativeKernel((const void*)fwd_megakernel, dim3(grid), dim3(NTHREADS), kargs, LDS_BYTES, stream);
    if (e != hipSuccess) fprintf(stderr, "cooperative launch failed: %s (grid %d)\n", hipGetErrorString(e), grid);
#else
#ifndef PROBE_REP
#define PROBE_REP -1
#endif
#ifndef PROBE_VAR
#define PROBE_VAR 0
#endif
    for (int p = 0; p < N_PHASES; ++p) { a.ph_lo = p; a.ph_hi = p + 1;
        for (int rep = 0; rep < (p == PROBE_REP ? 2 : 1); ++rep) { a.var = rep ? PROBE_VAR : 0; hipLaunchKernelGGL(fwd_megakernel, dim3(grid), dim3(NTHREADS), LDS_BYTES, stream, a); } }
#endif
}
```

```cpp
#include <hip/hip_runtime.h>
#include <hip/hip_cooperative_groups.h>
#include <cstdio>
#include <cstdint>
#include <cmath>
namespace cg = cooperative_groups;
namespace pg8 {
#define PG8_LAS __attribute__((address_space(3)))
typedef unsigned short bf16_t;
typedef short bf16x8 __attribute__((ext_vector_type(8)));
typedef float f32x4 __attribute__((ext_vector_type(4)));
typedef unsigned u32x4 __attribute__((ext_vector_type(4)));
constexpr int BM = 256, BK = 64, HALF = 128, HTB = HALF * BK * 2  , STAGE_BYTES = 8 * HTB, NXCD = 8, WGM = 8;

__host__ __device__ __forceinline__ int lds_byte(int r, int c) { const int st = (r >> 4) * 2 + (c >> 5), rr = r & 15, cc = c & 31, ob = rr * 64 + cc * 2; return st * 1024 + (ob ^ (((ob >> 9) & 1) << 5)); }
__host__ __device__ __forceinline__ void stage_rc(int b, int& R, int& C) { const int st = b / 1024, sb = b % 1024, swz = sb ^ (((sb >> 9) & 1) << 5); R = (st >> 1) * 16 + swz / 64; C = (st & 1) * 32 + (swz % 64) / 2; }
__host__ __device__ __forceinline__ int perm32(int rho) { const int n = rho >> 4, i = rho & 15; return 8 * (i >> 2) + 4 * n + (i & 3); }

struct Unit { int pm, pn; };
struct Gemm { const bf16_t* A; const bf16_t* Bt; int M, N, K; };

struct StaticOrder {
    int nM, nN, nwg, G, c;
    __host__ __device__ void init(int M, int N, int G_, int c_) { nM = M / BM; nN = N / BM; nwg = nM * nN; G = G_; c = c_; }
    __host__ __device__ bool next(int i, Unit& u) const {
        const long L = (long)i * G + c; if (L >= nwg) return false;
        int wgid = (int)L; { const int q = nwg / NXCD, r = nwg % NXCD, xcd = wgid % NXCD, off = wgid / NXCD; wgid = (xcd < r ? xcd * (q + 1) : r * (q + 1) + (xcd - r) * q) + off; }
        const int nig = WGM * nN, gid = wgid / nig, fm = gid * WGM, gsz = (nM - fm) < WGM ? (nM - fm) : WGM;
        u.pm = fm + ((wgid % nig) % gsz); u.pn = (wgid % nig) / gsz; return true;
    }
    __device__ __forceinline__ void a_ready(const Unit&) const {}
    __device__ __forceinline__ void done(const Unit&) const {}
};

__device__ __forceinline__ unsigned cvt_pk_bf16(float lo, float hi) { unsigned r; asm volatile("v_cvt_pk_bf16_f32 %0, %1, %2" : "=v"(r) : "v"(lo), "v"(hi)); return r; }
typedef float f32x2 __attribute__((ext_vector_type(2)));

typedef unsigned u32x4e __attribute__((ext_vector_type(4)));
__device__ __forceinline__ float bf_lo(unsigned w) { return __builtin_bit_cast(float, w << 16); }
__device__ __forceinline__ float bf_hi(unsigned w) { return __builtin_bit_cast(float, w & 0xffff0000u); }
__device__ __forceinline__ float sigmoidf_fast(float x) { return __builtin_amdgcn_rcpf(1.0f + __builtin_amdgcn_exp2f(-1.4426950408889634f * x)); }
constexpr int LDP = 10752;
constexpr int SEQ_ = 8192;
constexpr size_t R_FQ = 0, R_FK = (size_t)SEQ_ * 1024, R_FV = (size_t)2 * SEQ_ * 1024, R_SQ = (size_t)3 * SEQ_ * 1024, R_SK = (size_t)4 * SEQ_ * 1024, R_SV = R_SK + (size_t)SEQ_ * 256,
                 R_GF = R_SV + (size_t)SEQ_ * 256, R_GS = R_GF + (size_t)SEQ_ * 1024, R_MF = R_GS + (size_t)SEQ_ * 1024, R_MS = R_MF + (size_t)SEQ_ * 2048;
constexpr int C_FQ = 0, C_FK = 1024, C_FV = 2048, C_SQ = 3072, C_SK = 4096, C_SV = 4352, C_GF = 4608, C_GS = 5632, C_MF = 6656, C_MS = 8704;
constexpr float QS_FOX = 0.08838834764831845f * 1.4426950408889634f;
constexpr float QS_SWA = 0.125f * 1.4426950408889634f;

struct EpiProj {
    static constexpr bool PERM = true, AFTER_DRAIN = false, MIDHOOK = false;
    bf16_t* O;
    __device__ __forceinline__ void operator()(const f32x4 (&acc)[2][2][4][2], const Unit& u, int wr, int wc, int fr, int fq) const {
        const int pn = u.pn;
        int mode = 0; float sc = 1.f;
        size_t boff; int c0, rs, hsh;
        if (pn < 12) { const int t = pn >> 2; boff = (size_t)t * SEQ_ * 1024; c0 = t * 1024; rs = 128; hsh = 7; if (t == 0) sc = QS_FOX; }
        else if (pn < 16) { boff = (size_t)3 * SEQ_ * 1024; c0 = 3072; rs = 64; hsh = 6; sc = QS_SWA; }
        else if (pn < 18) { boff = (size_t)4 * SEQ_ * 1024 + (size_t)(pn - 16) * SEQ_ * 256; c0 = 4096 + (pn - 16) * 256; rs = 64; hsh = 6; }
        else if (pn < 26) { const int t = (pn - 18) >> 2; boff = (size_t)4 * SEQ_ * 1024 + (size_t)SEQ_ * 512 + (size_t)t * SEQ_ * 1024; c0 = 4608 + t * 1024; rs = 1024; hsh = 31; mode = 1; }
        else { const int t = (pn - 26) >> 3; boff = (size_t)6 * SEQ_ * 1024 + (size_t)SEQ_ * 512 + (size_t)t * SEQ_ * 2048; c0 = 6656 + t * 2048; rs = 2048; hsh = 31; mode = 2; }
        const int row0 = u.pm * BM + wr * 64 + fr; const int crel0 = pn * BM + wc * 32 + 8 * fq - c0;
#pragma unroll
        for (int bj = 0; bj < 2; ++bj) { const int crel = crel0 + bj * HALF;
            const int head = (hsh == 31) ? 0 : (crel >> hsh), d = (hsh == 31) ? crel : (crel & ((1 << hsh) - 1));
            bf16_t* colp = O + boff + (size_t)head * SEQ_ * rs + d;
#pragma unroll
            for (int ai = 0; ai < 2; ++ai)
#pragma unroll
                for (int m = 0; m < 4; ++m) { f32x4 v0 = acc[ai][bj][m][0], v1 = acc[ai][bj][m][1];
                    if (mode == 0) { v0 = v0 * sc; v1 = v1 * sc; }
                    else {
#pragma unroll
                        for (int e = 0; e < 4; ++e) { const float s0 = sigmoidf_fast(v0[e]), s1 = sigmoidf_fast(v1[e]); v0[e] = (mode == 1) ? v0[e] * s0 : s0; v1[e] = (mode == 1) ? v1[e] * s1 : s1; }
                    }
                    u32x4e w; w.x = cvt_pk_bf16(v0[0], v0[1]); w.y = cvt_pk_bf16(v0[2], v0[3]); w.z = cvt_pk_bf16(v1[0], v1[1]); w.w = cvt_pk_bf16(v1[2], v1[3]);
                    *(u32x4e*)(colp + (size_t)(row0 + ai * HALF + m * 16) * rs) = w; } }
    }
};
struct EpiPartial {
    static constexpr bool PERM = true, AFTER_DRAIN = false, MIDHOOK = false;
    float* part; const bf16_t* sig;
    __device__ __forceinline__ void operator()(const f32x4 (&acc)[2][2][4][2], const Unit& u, int wr, int wc, int fr, int fq) const {
        const int row0 = u.pm * BM + wr * 64 + fr; const int col0 = u.pn * BM + wc * 32 + 8 * fq;
#pragma unroll
        for (int ai = 0; ai < 2; ++ai)
#pragma unroll
            for (int m = 0; m < 4; ++m) { const size_t r = (size_t)(row0 + ai * HALF + m * 16);
#pragma unroll
                for (int bj = 0; bj < 2; ++bj) { const int c = col0 + bj * HALF;
                    const u32x4e s = *(const u32x4e*)(sig + r * 2048 + c);
                    f32x4 v0 = acc[ai][bj][m][0], v1 = acc[ai][bj][m][1];
                    v0[0] *= bf_lo(s.x); v0[1] *= bf_hi(s.x); v0[2] *= bf_lo(s.y); v0[3] *= bf_hi(s.y);
                    v1[0] *= bf_lo(s.z); v1[1] *= bf_hi(s.z); v1[2] *= bf_lo(s.w); v1[3] *= bf_hi(s.w);
                    float* p = part + r * 2048 + c; *(f32x4*)p = v0; *(f32x4*)(p + 4) = v1; }
                asm volatile("" ::: "memory"); }
    }
};
struct EpiMerge {
    static constexpr bool PERM = true, AFTER_DRAIN = false, MIDHOOK = false;
    const float* part; const bf16_t* sig; bf16_t* O;
    __device__ __forceinline__ void operator()(const f32x4 (&acc)[2][2][4][2], const Unit& u, int wr, int wc, int fr, int fq) const {
        const int row0 = u.pm * BM + wr * 64 + fr; const int col0 = u.pn * BM + wc * 32 + 8 * fq;
#pragma unroll
        for (int ai = 0; ai < 2; ++ai)
#pragma unroll
            for (int m = 0; m < 4; ++m) { const size_t r = (size_t)(row0 + ai * HALF + m * 16);
#pragma unroll
                for (int bj = 0; bj < 2; ++bj) { const int c = col0 + bj * HALF;
                    const u32x4e s = *(const u32x4e*)(sig + r * 2048 + c);
                    const float* p = part + r * 2048 + c; const f32x4 p0 = *(const f32x4*)p, p1 = *(const f32x4*)(p + 4);
                    f32x4 v0 = acc[ai][bj][m][0], v1 = acc[ai][bj][m][1];
                    v0[0] = p0[0] + v0[0] * bf_lo(s.x); v0[1] = p0[1] + v0[1] * bf_hi(s.x); v0[2] = p0[2] + v0[2] * bf_lo(s.y); v0[3] = p0[3] + v0[3] * bf_hi(s.y);
                    v1[0] = p1[0] + v1[0] * bf_lo(s.z); v1[1] = p1[1] + v1[1] * bf_hi(s.z); v1[2] = p1[2] + v1[2] * bf_lo(s.w); v1[3] = p1[3] + v1[3] * bf_hi(s.w);
                    u32x4e w; w.x = cvt_pk_bf16(v0[0], v0[1]); w.y = cvt_pk_bf16(v0[2], v0[3]); w.z = cvt_pk_bf16(v1[0], v1[1]); w.w = cvt_pk_bf16(v1[2], v1[3]);
                    *(u32x4e*)(O + r * 2048 + c) = w; }
                asm volatile("" ::: "memory"); }
    }
};
struct EpiMerge2 {
    static constexpr bool PERM = true, AFTER_DRAIN = false, MIDHOOK = true;
    const bf16_t* sig1; const bf16_t* sig2; bf16_t* O;
    __device__ __forceinline__ void mid(f32x4 (&acc)[2][2][4][2], const Unit& u, int wr, int wc, int fr, int fq) const {
        int row0 = u.pm * BM + wr * 64 + fr, col0 = u.pn * BM + wc * 32 + 8 * fq; asm volatile("" : "+v"(row0), "+v"(col0));
#pragma unroll
        for (int ai = 0; ai < 2; ++ai)
#pragma unroll
            for (int m = 0; m < 4; ++m) { const size_t ro = (size_t)(row0 + ai * HALF + m * 16) * 2048 + col0;
#pragma unroll
                for (int bj = 0; bj < 2; ++bj)
#pragma unroll
                    for (int n = 0; n < 2; ++n) {
                        const unsigned long long a = *(const unsigned long long*)(sig1 + ro + bj * HALF + 4 * n), b = *(const unsigned long long*)(sig2 + ro + bj * HALF + 4 * n);
                        const unsigned a0 = (unsigned)a, a1 = (unsigned)(a >> 32), b0 = (unsigned)b, b1 = (unsigned)(b >> 32);
                        f32x4 v = acc[ai][bj][m][n];
                        v[0] *= bf_lo(a0) * __builtin_amdgcn_rcpf(fmaxf(bf_lo(b0), 1e-30f)); v[1] *= bf_hi(a0) * __builtin_amdgcn_rcpf(fmaxf(bf_hi(b0), 1e-30f));
                        v[2] *= bf_lo(a1) * __builtin_amdgcn_rcpf(fmaxf(bf_lo(b1), 1e-30f)); v[3] *= bf_hi(a1) * __builtin_amdgcn_rcpf(fmaxf(bf_hi(b1), 1e-30f));
                        acc[ai][bj][m][n] = v;
                        asm volatile("" ::: "memory"); } }
    }
    __device__ __forceinline__ void operator()(const f32x4 (&acc)[2][2][4][2], const Unit& u, int wr, int wc, int fr, int fq) const {
        int row0 = u.pm * BM + wr * 64 + fr, col0 = u.pn * BM + wc * 32 + 8 * fq; asm volatile("" : "+v"(row0), "+v"(col0));
#pragma unroll
        for (int ai = 0; ai < 2; ++ai)
#pragma unroll
            for (int m = 0; m < 4; ++m) { const size_t r = (size_t)(row0 + ai * HALF + m * 16);
#pragma unroll
                for (int bj = 0; bj < 2; ++bj) { const int c = col0 + bj * HALF;
                    const u32x4e b = *(const u32x4e*)(sig2 + r * 2048 + c);
                    f32x4 v0 = acc[ai][bj][m][0], v1 = acc[ai][bj][m][1];
                    u32x4e w; w.x = cvt_pk_bf16(v0[0] * bf_lo(b.x), v0[1] * bf_hi(b.x)); w.y = cvt_pk_bf16(v0[2] * bf_lo(b.y), v0[3] * bf_hi(b.y));
                    w.z = cvt_pk_bf16(v1[0] * bf_lo(b.z), v1[1] * bf_hi(b.z)); w.w = cvt_pk_bf16(v1[2] * bf_lo(b.w), v1[3] * bf_hi(b.w));
                    *(u32x4e*)(O + r * 2048 + c) = w; }
                asm volatile("" ::: "memory"); }
    }
};
struct EpiZ {
    static constexpr bool PERM = true, AFTER_DRAIN = false, MIDHOOK = false;
    const float* x; const float* gate; float* z; float alpha;
    __device__ __forceinline__ void operator()(const f32x4 (&acc)[2][2][4][2], const Unit& u, int wr, int wc, int fr, int fq) const {
        const int row0 = u.pm * BM + wr * 64 + fr; const int col0 = u.pn * BM + wc * 32 + 8 * fq;
#pragma unroll
        for (int bj = 0; bj < 2; ++bj) { const int c = col0 + bj * HALF;
            const f32x4 g0 = *(const f32x4*)(gate + c), g1 = *(const f32x4*)(gate + c + 4);
#pragma unroll
            for (int ai = 0; ai < 2; ++ai)
#pragma unroll
                for (int m = 0; m < 4; ++m) { const size_t r = (size_t)(row0 + ai * HALF + m * 16);
                    const float* xp = x + r * 2048 + c; const f32x4 x0 = *(const f32x4*)xp, x1 = *(const f32x4*)(xp + 4);
                    const f32x4 v0 = x0 * alpha + g0 * acc[ai][bj][m][0], v1 = x1 * alpha + g1 * acc[ai][bj][m][1];
                    float* zp = z + r * 2048 + c; *(f32x4*)zp = v0; *(f32x4*)(zp + 4) = v1;
                    asm volatile("" ::: "memory"); } }
    }
};

template <class Epi, class Sched, bool ALIGN_EPI = false, bool SP2 = false>
__device__ __forceinline__ void gemm_phase(PG8_LAS unsigned char* lds, const Gemm g, const Sched& S, const Epi& E) {
    const int tid = threadIdx.x, wid = __builtin_amdgcn_readfirstlane(tid >> 6), lane = tid & 63, wr = wid >> 2, wc = wid & 3, fr = lane & 15, fq = lane >> 4;
    const int K = g.K, nt = K / BK;
    unsigned voffA[2], voffB[2];
#pragma unroll
    for (int i = 0; i < 2; ++i) { int R, C; stage_rc(tid * 16 + i * 8192, R, C); const int Rb = Epi::PERM ? ((R & ~31) + perm32(R & 31)) : R;
        voffA[i] = (unsigned)(R * K + C) * 2u; voffB[i] = (unsigned)(Rb * K + C) * 2u; }
    const size_t kstep = (size_t)(BK * 2);
    const size_t hstep = (size_t)HALF * K * 2;
    const size_t tstep = 2 * hstep;
    const unsigned ldsw = (unsigned)wid * 1024u;
    const int aoff = lds_byte(wr * 64 + fr, fq * 8), boff = lds_byte(wc * 32 + fr, fq * 8);
#define PG8_SA(b, h) (((b) * 2 + (h)) * HTB)
#define PG8_SB(b, h) ((4 + (b) * 2 + (h)) * HTB)
#define PG8_STAGE(bufoff, gbase, voff) do { _Pragma("unroll") for (int _i = 0; _i < 2; ++_i) \
        __builtin_amdgcn_global_load_lds((const unsigned*)((const char*)(gbase) + (voff)[_i]), (PG8_LAS unsigned*)(lds + (bufoff) + ldsw + _i * 8192), 16, 0, 0); } while (0)
#define PG8_LDA(dst, b, h) do { _Pragma("unroll") for (int m = 0; m < 4; ++m) _Pragma("unroll") for (int k = 0; k < 2; ++k) dst[m][k] = *(const PG8_LAS bf16x8*)(lds + PG8_SA(b, h) + aoff + m * 2048 + k * 1024); } while (0)
#define PG8_LDB(dst, b, h) do { _Pragma("unroll") for (int n = 0; n < 2; ++n) _Pragma("unroll") for (int k = 0; k < 2; ++k) dst[n][k] = *(const PG8_LAS bf16x8*)(lds + PG8_SB(b, h) + boff + n * 2048 + k * 1024); } while (0)
#define PG8_MMA(ai, bj, At, Bt) do { __builtin_amdgcn_s_setprio(1); _Pragma("unroll") for (int m = 0; m < 4; ++m) _Pragma("unroll") for (int n = 0; n < 2; ++n) _Pragma("unroll") for (int k = 0; k < 2; ++k) \
        acc[ai][bj][m][n] = __builtin_amdgcn_mfma_f32_16x16x32_bf16(Bt[n][k], At[m][k], acc[ai][bj][m][n], 0, 0, 0); __builtin_amdgcn_s_setprio(0); } while (0)
#define PG8_WAIT_V(n) asm volatile("s_waitcnt vmcnt(" #n ")" ::: "memory")
#define PG8_WAIT_L(n) asm volatile("s_waitcnt lgkmcnt(" #n ")" ::: "memory")
#define PG8_BAR __builtin_amdgcn_s_barrier()
#define PG8_SCHED __builtin_amdgcn_sched_barrier(0)
    Unit cur, nxt; int ui = 0;
    if (!S.next(0, cur)) return;
    f32x4 acc[2][2][4][2];
#pragma unroll
    for (int a = 0; a < 2; ++a)
#pragma unroll
        for (int b = 0; b < 2; ++b)
#pragma unroll
            for (int m = 0; m < 4; ++m)
#pragma unroll
                for (int n = 0; n < 2; ++n) acc[a][b][m][n] = (f32x4){0.f, 0.f, 0.f, 0.f};
    bf16x8 At[4][2], B0[2][2], B1[2][2];
    const char* cA = (const char*)g.A + (size_t)cur.pm * tstep; const char* cB = (const char*)g.Bt + (size_t)cur.pn * tstep;
    S.a_ready(cur);
    if constexpr (SP2) {
        PG8_STAGE(PG8_SB(0, 0), cB, voffB); PG8_STAGE(PG8_SB(0, 1), cB + hstep, voffB); PG8_STAGE(PG8_SA(0, 0), cA, voffA); PG8_STAGE(PG8_SA(0, 1), cA + hstep, voffA);
        if (wr == 1) PG8_BAR;
        PG8_WAIT_V(2); PG8_BAR;
        PG8_STAGE(PG8_SB(1, 0), cB + kstep, voffB); PG8_STAGE(PG8_SA(1, 0), cA + kstep, voffA); PG8_STAGE(PG8_SB(1, 1), cB + hstep + kstep, voffB);
        PG8_WAIT_V(6); PG8_BAR;
    } else {
        PG8_STAGE(PG8_SB(0, 0), cB, voffB); PG8_STAGE(PG8_SA(0, 0), cA, voffA); PG8_STAGE(PG8_SB(0, 1), cB + hstep, voffB); PG8_STAGE(PG8_SA(0, 1), cA + hstep, voffA);
        if (wr == 1) PG8_BAR;
        PG8_WAIT_V(4); PG8_BAR;
        PG8_STAGE(PG8_SB(1, 0), cB + kstep, voffB); PG8_STAGE(PG8_SA(1, 0), cA + kstep, voffA); PG8_STAGE(PG8_SB(1, 1), cB + hstep + kstep, voffB);
        PG8_WAIT_V(6); PG8_BAR;
    }
    for (;;) {
        const bool has_next = S.next(ui + 1, nxt);
        const char* nA = has_next ? (const char*)g.A + (size_t)nxt.pm * tstep : cA; const char* nB = has_next ? (const char*)g.Bt + (size_t)nxt.pn * tstep : cB;
        for (int t = 0; t < nt; t += 2) {
            if constexpr (Epi::MIDHOOK) { if (t == (nt >> 1)) E.mid(acc, cur, wr, wc, fr, fq); }
            const bool last = (t == nt - 2);
            const char* a1 = cA + (size_t)(t + 1) * kstep;
            const char* a2 = last ? nA : cA + (size_t)(t + 2) * kstep; const char* b2 = last ? nB : cB + (size_t)(t + 2) * kstep;
            const char* a3 = a2 + kstep; const char* b3 = b2 + kstep;
            if (last && has_next) S.a_ready(nxt);
            if constexpr (SP2) {
            PG8_LDB(B0, 0, 0); PG8_LDB(B1, 0, 1); PG8_SCHED; PG8_LDA(At, 0, 0); PG8_STAGE(PG8_SA(1, 1), a1 + hstep, voffA);
            PG8_WAIT_V(8); PG8_WAIT_L(0); PG8_BAR; PG8_MMA(0, 0, At, B0); PG8_MMA(0, 1, At, B1); PG8_BAR; PG8_SCHED;
            PG8_LDA(At, 0, 1); PG8_STAGE(PG8_SB(0, 0), b2, voffB); PG8_STAGE(PG8_SB(0, 1), b2 + hstep, voffB); PG8_STAGE(PG8_SA(0, 0), a2, voffA);
            PG8_WAIT_V(8); PG8_WAIT_L(0); PG8_BAR; PG8_MMA(1, 0, At, B0); PG8_MMA(1, 1, At, B1); PG8_BAR; PG8_SCHED;
            PG8_LDB(B0, 1, 0); PG8_LDB(B1, 1, 1); PG8_SCHED; PG8_LDA(At, 1, 0); PG8_STAGE(PG8_SA(0, 1), a2 + hstep, voffA);
            PG8_WAIT_V(8); PG8_WAIT_L(0); PG8_BAR; PG8_MMA(0, 0, At, B0); PG8_MMA(0, 1, At, B1); PG8_BAR; PG8_SCHED;
            PG8_LDA(At, 1, 1); PG8_STAGE(PG8_SB(1, 0), b3, voffB); PG8_STAGE(PG8_SB(1, 1), b3 + hstep, voffB); PG8_STAGE(PG8_SA(1, 0), a3, voffA);
            PG8_WAIT_V(8); PG8_WAIT_L(0); PG8_BAR; PG8_MMA(1, 0, At, B0); PG8_MMA(1, 1, At, B1); PG8_BAR; PG8_SCHED;
            } else {
            PG8_LDB(B0, 0, 0); PG8_SCHED; PG8_LDA(At, 0, 0); PG8_STAGE(PG8_SA(1, 1), a1 + hstep, voffA);
            PG8_WAIT_L(8); PG8_BAR; PG8_WAIT_L(0); PG8_MMA(0, 0, At, B0); PG8_BAR; PG8_SCHED;
            PG8_LDB(B1, 0, 1); PG8_STAGE(PG8_SB(0, 0), b2, voffB);
            PG8_BAR; PG8_WAIT_L(0); PG8_MMA(0, 1, At, B1); PG8_BAR;
            PG8_LDA(At, 0, 1); PG8_STAGE(PG8_SA(0, 0), a2, voffA);
            PG8_BAR; PG8_WAIT_L(0); PG8_MMA(1, 0, At, B0); PG8_BAR; PG8_SCHED;
            PG8_STAGE(PG8_SB(0, 1), b2 + hstep, voffB);
            PG8_WAIT_V(6); PG8_BAR; PG8_MMA(1, 1, At, B1); PG8_BAR;
            PG8_LDB(B0, 1, 0); PG8_SCHED; PG8_LDA(At, 1, 0); PG8_STAGE(PG8_SA(0, 1), a2 + hstep, voffA);
            PG8_WAIT_L(8); PG8_BAR; PG8_WAIT_L(0); PG8_MMA(0, 0, At, B0); PG8_BAR; PG8_SCHED;
            PG8_LDB(B1, 1, 1); PG8_STAGE(PG8_SB(1, 0), b3, voffB);
            PG8_BAR; PG8_WAIT_L(0); PG8_MMA(0, 1, At, B1); PG8_BAR;
            PG8_LDA(At, 1, 1); PG8_STAGE(PG8_SA(1, 0), a3, voffA);
            PG8_BAR; PG8_WAIT_L(0); PG8_MMA(1, 0, At, B0); PG8_BAR; PG8_SCHED;
            PG8_STAGE(PG8_SB(1, 1), b3 + hstep, voffB);
            PG8_WAIT_V(6); PG8_BAR; PG8_MMA(1, 1, At, B1); PG8_BAR;
            }
        }
        if constexpr (ALIGN_EPI) { if (wr == 0) PG8_BAR; }
        if constexpr (!Epi::AFTER_DRAIN) { E(acc, cur, wr, wc, fr, fq); S.done(cur); }
        if (!has_next) break;
#pragma unroll
        for (int a = 0; a < 2; ++a)
#pragma unroll
            for (int b = 0; b < 2; ++b)
#pragma unroll
                for (int m = 0; m < 4; ++m)
#pragma unroll
                    for (int n = 0; n < 2; ++n) acc[a][b][m][n] = (f32x4){0.f, 0.f, 0.f, 0.f};
        cur = nxt; cA = nA; cB = nB; ++ui;
        if constexpr (ALIGN_EPI) { if (wr == 1) PG8_BAR; }
    }
    PG8_WAIT_V(0);
    if constexpr (!ALIGN_EPI) { if (wr == 0) PG8_BAR; }
    PG8_BAR;
    if constexpr (Epi::AFTER_DRAIN) { E.fused(acc, cur, wr, wc, fr, fq, lds, wid, lane); S.done(cur); }
#undef PG8_SA
#undef PG8_SB
#undef PG8_STAGE
#undef PG8_LDA
#undef PG8_LDB
#undef PG8_MMA
#undef PG8_WAIT_V
#undef PG8_WAIT_L
#undef PG8_BAR
#undef PG8_SCHED
}
}

#define GAS __attribute__((address_space(1)))
#define LAS __attribute__((address_space(3)))
typedef unsigned short bf16;
typedef unsigned v4u __attribute__((ext_vector_type(4)));
typedef unsigned v2u __attribute__((ext_vector_type(2)));
typedef float f32x4 __attribute__((ext_vector_type(4)));
typedef short bf16x8 __attribute__((ext_vector_type(8)));
typedef float f32x16 __attribute__((ext_vector_type(16)));
#define LDS_WAIT() asm volatile("s_waitcnt lgkmcnt(0)" ::: "memory")

constexpr int SEQ = 8192, DM = 2048, NIN = 10760, NWAVES = 8, NTHREADS = 512;
constexpr int LDP = pg8::LDP;
constexpr float LN_EPS = 1e-5f;
constexpr float LOG2E = 1.4426950408889634f;
constexpr float DN_ALPHA = 1.189207115002721f;
constexpr float NEG_BIG = -1e30f;

constexpr size_t MiB = 1u << 20;
constexpr size_t WS_ADA = 0;
constexpr size_t WS_BAR = 32 * 1024, WS_BAR_BYTES = 16 * 1024;
constexpr size_t WS_LOGF = 64 * 1024;
constexpr size_t WS_CUM = WS_LOGF + 256 * 1024;
constexpr size_t WS_WIN_T = 1 * MiB;
constexpr size_t WS_WBF_T = 44 * MiB;
constexpr size_t WS_WBS_T = 48 * MiB;
constexpr size_t WS_WOUT_T = 52 * MiB;
constexpr size_t WS_H = 64 * MiB;
constexpr size_t WS_PROJ = 96 * MiB;
constexpr size_t WS_AF = 264 * MiB;
constexpr size_t WS_AS = 280 * MiB;
constexpr size_t WS_END = 296 * MiB;
constexpr size_t WS_SCR = 296 * MiB;

constexpr int LDS_BYTES = 147456, LDS_MISC_OFF = LDS_BYTES - 64;

__device__ __forceinline__ unsigned f2bf(float f) { unsigned u = __builtin_bit_cast(unsigned, f); return (u + 0x7fffu + ((u >> 16) & 1u)) >> 16; }
__device__ __forceinline__ unsigned pk2(float lo, float hi) { return f2bf(lo) | (f2bf(hi) << 16); }
__device__ __forceinline__ float bf2f(bf16 v) { return __builtin_bit_cast(float, (unsigned)v << 16); }
__device__ __forceinline__ float wave_sum(float v) {
#pragma unroll
    for (int o = 1; o < 64; o <<= 1) v += __shfl_xor(v, o);
    return v;
}
__device__ __forceinline__ float wave_max(float v) {
#pragma unroll
    for (int o = 1; o < 64; o <<= 1) v = fmaxf(v, __shfl_xor(v, o));
    return v;
}

struct Args { const float* in[12]; float* out; unsigned char* ws; int ph_lo, ph_hi, var, pad; };

__device__ __forceinline__ void p0_transpose_item(const float* W, int K, int ldw, int N, bf16* WT, int ldt, LAS float* scr, int item, int lane) {
    const int nblk = N / 32, kb = item / nblk, nb = item % nblk, k0 = 64 * kb, n0 = 32 * nb;
#pragma unroll 8
    for (int i = 0; i < 32; ++i) { const int kk = 2 * i + (lane >> 5); scr[kk * 33 + (lane & 31)] = W[(size_t)(k0 + kk) * ldw + n0 + (lane & 31)]; }
    LDS_WAIT(); asm volatile("" ::: "memory");
    const int c = lane & 7;
#pragma unroll
    for (int j = 0; j < 4; ++j) { const int n = (lane >> 3) + 8 * j; const LAS float* s = scr + (8 * c) * 33 + n;
        v4u o; o.x = pk2(s[0 * 33], s[1 * 33]); o.y = pk2(s[2 * 33], s[3 * 33]); o.z = pk2(s[4 * 33], s[5 * 33]); o.w = pk2(s[6 * 33], s[7 * 33]);
        *(v4u*)(WT + (size_t)(n0 + n) * ldt + k0 + 8 * c) = o; }
    LDS_WAIT(); asm volatile("" ::: "memory");
}

__device__ __forceinline__ void phase0(const Args& a, LAS unsigned char* lds) {
    const int tid = threadIdx.x, lane = tid & 63, wave = tid >> 6, G = gridDim.x;
    const float* c = a.in[1]; const float* w_ada = a.in[2]; const float* b_ada = a.in[3];
    float* ada = (float*)(a.ws + WS_ADA);
    LAS float* red = (LAS float*)lds;
    for (int cb = blockIdx.x; cb < 256; cb += G) {
        const int c4 = tid % 6, ks = tid / 6;
        f32x4 acc = {0.f, 0.f, 0.f, 0.f};
        if (ks < 85) {
            for (int k = ks; k < DM; k += 85) { const f32x4 w = *(const f32x4*)(w_ada + (size_t)k * 6144 + 24 * cb + 4 * c4); acc += w * c[k]; }
            *(LAS f32x4*)(red + ks * 24 + 4 * c4) = acc;
        }
        __syncthreads();
        if (tid < 24) { float s = 0.f; for (int i = 0; i < 85; ++i) s += red[i * 24 + tid]; ada[24 * cb + tid] = s + b_ada[24 * cb + tid]; }
        __syncthreads();
    }
    LAS float* scr = (LAS float*)(lds + wave * 16384);
    const int gw = blockIdx.x * NWAVES + wave, NGW = G * NWAVES;
    const float* w_in = a.in[4];
    constexpr int I_A = (DM / 64) * (3072 / 32), I_B = (DM / 64) * (7680 / 32), I_F = (1024 / 64) * (DM / 32), I_O = (DM / 64) * (DM / 32);
    constexpr int NITEMS = I_A + I_B + 2 * I_F + I_O;
    bf16* win_t = (bf16*)(a.ws + WS_WIN_T);
    for (int it = gw; it < NITEMS; it += NGW) {
        int r = it;
        if (r < I_A) { p0_transpose_item(w_in, DM, NIN, 3072, win_t, DM, scr, r, lane); continue; } r -= I_A;
        if (r < I_B) { p0_transpose_item(w_in + 3080, DM, NIN, 7680, win_t + (size_t)3072 * DM, DM, scr, r, lane); continue; } r -= I_B;
        if (r < I_F) { p0_transpose_item(a.in[7], 1024, DM, DM, (bf16*)(a.ws + WS_WBF_T), DM, scr, r, lane); continue; } r -= I_F;
        if (r < I_F) { p0_transpose_item(a.in[8], 1024, DM, DM, (bf16*)(a.ws + WS_WBF_T) + 1024, DM, scr, r, lane); continue; } r -= I_F;
        p0_transpose_item(a.in[9], DM, DM, DM, (bf16*)(a.ws + WS_WOUT_T), DM, scr, r, lane);
    }
}

__device__ __forceinline__ void phase1(const Args& a, LAS unsigned char* lds) {
    const int tid = threadIdx.x, lane = tid & 63, wave = tid >> 6, G = gridDim.x;
    const float* x = a.in[0]; const float* w_in = a.in[4]; const float* b_f = a.in[5];
    const float* ada = (const float*)(a.ws + WS_ADA);
    bf16* H = (bf16*)(a.ws + WS_H);
    float* logf_ = (float*)(a.ws + WS_LOGF);
    LAS f32x4* w8 = (LAS f32x4*)lds;
    for (int i = tid; i < 4096; i += NTHREADS) { const int k = i >> 1, half = i & 1; const int l = (k >> 2) & 63, e = k & 3, j = k >> 8;
        w8[((half * 4 + e) * 8 + j) * 64 + l] = *(const f32x4*)(w_in + (size_t)k * NIN + 3072 + 4 * half); }
    __syncthreads();
    const int gw = blockIdx.x * NWAVES + wave, NGW = G * NWAVES;
    for (int m = gw; m < SEQ; m += NGW) {
        const f32x4* xr = (const f32x4*)(x + (size_t)m * DM) + lane;
        f32x4 v[8]; float s = 0.f;
#pragma unroll
        for (int j = 0; j < 8; ++j) { v[j] = xr[64 * j]; s += (v[j].x + v[j].y) + (v[j].z + v[j].w); }
        const float mean = wave_sum(s) * (1.f / DM); float s2 = 0.f;
#pragma unroll
        for (int j = 0; j < 8; ++j) { v[j] = v[j] - mean; s2 += (v[j].x * v[j].x + v[j].y * v[j].y) + (v[j].z * v[j].z + v[j].w * v[j].w); }
        const float rstd = 1.f / sqrtf(wave_sum(s2) * (1.f / DM) + LN_EPS);
        f32x4 al = {0.f, 0.f, 0.f, 0.f}, ah = {0.f, 0.f, 0.f, 0.f};
        v2u* o8 = (v2u*)(H + (size_t)m * DM) + lane;
#pragma unroll
        for (int j = 0; j < 8; ++j) {
            asm volatile("" ::: "memory");
            const f32x4 sh = *((const f32x4*)ada + lane + 64 * j), sc = *((const f32x4*)(ada + DM) + lane + 64 * j);
            const f32x4 hv = v[j] * rstd * (sc + 1.0f) + sh;
            v2u o; o.x = pk2(hv.x, hv.y); o.y = pk2(hv.z, hv.w); o8[64 * j] = o;
#pragma unroll
            for (int e = 0; e < 4; ++e) { const f32x4 wl = w8[((0 + e) * 8 + j) * 64 + lane], wh = w8[((4 + e) * 8 + j) * 64 + lane]; al += wl * hv[e]; ah += wh * hv[e]; }
        }
        float r8[8] = {al.x, al.y, al.z, al.w, ah.x, ah.y, ah.z, ah.w};
#pragma unroll
        for (int hh = 0; hh < 8; ++hh) r8[hh] = wave_sum(r8[hh]);
        if (lane < 8) { float t = r8[0];
#pragma unroll
            for (int hh = 1; hh < 8; ++hh) t = (lane == hh) ? r8[hh] : t;
            const float xx = t + b_f[lane];
            logf_[lane * SEQ + m] = fminf(xx, 0.f) - log1pf(expf(-fabsf(xx))); }
    }
}

__device__ __forceinline__ void scan_head(const Args& a, LAS unsigned char* lds, int h) {
    const int tid = threadIdx.x;
    const float* src = (const float*)(a.ws + WS_LOGF) + (size_t)h * SEQ + 16 * tid;
    float* dst = (float*)(a.ws + WS_CUM) + (size_t)h * SEQ + 16 * tid;
    LAS float* tot = (LAS float*)lds;
    float v[16];
#pragma unroll
    for (int i = 0; i < 4; ++i) { const f32x4 t = *((const f32x4*)src + i); v[4 * i] = t.x; v[4 * i + 1] = t.y; v[4 * i + 2] = t.z; v[4 * i + 3] = t.w; }
#pragma unroll
    for (int i = 1; i < 16; ++i) v[i] += v[i - 1];
    tot[tid] = v[15];
    __syncthreads();
    float base = 0.f;
    for (int i = 0; i < tid; ++i) base += tot[i];
#pragma unroll
    for (int i = 0; i < 4; ++i) { f32x4 t = {v[4 * i] + base, v[4 * i + 1] + base, v[4 * i + 2] + base, v[4 * i + 3] + base}; *((f32x4*)dst + i) = t; }
    __syncthreads();
}

template <bool FOX>
__device__ __forceinline__ void naive_attn(const Args& a, LAS unsigned char* lds) {
    constexpr int D = FOX ? 128 : 64, NH = FOX ? 8 : 16;
    const int tid = threadIdx.x, lane = tid & 63, wave = tid >> 6, G = gridDim.x;
    const bf16* P = (const bf16*)(a.ws + WS_PROJ);
    const float* cum = (const float*)(a.ws + WS_CUM);
    const float* sinks = a.in[6];
    bf16* O = (bf16*)(a.ws + WS_AF) + (FOX ? 0 : 1024);
    LAS float* qs = (LAS float*)(lds + wave * 1024);
    LAS float* ps = qs + 128;
    const int gw = blockIdx.x * NWAVES + wave, NGW = G * NWAVES;
    for (int row = gw; row < SEQ * NH; row += NGW) {
        const int t = row / NH, h = row % NH;
        const bf16* Qr = P + (FOX ? pg8::R_FQ : pg8::R_SQ) + ((size_t)h * SEQ + t) * D;
        const bf16* Kb = P + (FOX ? pg8::R_FK + (size_t)h * SEQ * D : pg8::R_SK + (size_t)(h >> 2) * SEQ * D);
        const bf16* Vb = P + (FOX ? pg8::R_FV + (size_t)h * SEQ * D : pg8::R_SV + (size_t)(h >> 2) * SEQ * D);
        const bf16* Gr = P + (FOX ? pg8::R_GF : pg8::R_GS) + (size_t)t * 1024 + h * D;
        if (FOX) { qs[2 * lane] = bf2f(Qr[2 * lane]); qs[2 * lane + 1] = bf2f(Qr[2 * lane + 1]); }
        else qs[lane] = bf2f(Qr[lane]);
        LDS_WAIT();
        const float Ft = FOX ? cum[h * SEQ + t] : 0.f;
        const float slope2 = FOX ? 0.f : exp2f(-8.0f * (float)(h + 1) / 16.0f) * LOG2E;
        const int lo = FOX ? 0 : (t - 127 > 0 ? t - 127 : 0);
        float mrun = NEG_BIG, l = 0.f, o0 = 0.f, o1 = 0.f;
        for (int s0 = lo; s0 <= t; s0 += 64) {
            const int s = s0 + lane; const bool valid = s <= t;
            float xv = NEG_BIG;
            if (valid) { const bf16* kr = Kb + (size_t)s * D; float dot = 0.f;
                for (int d = 0; d < D; d += 8) { const v4u kk = *(const v4u*)(kr + d);
                    dot += qs[d] * pg8::bf_lo(kk.x) + qs[d + 1] * pg8::bf_hi(kk.x) + qs[d + 2] * pg8::bf_lo(kk.y) + qs[d + 3] * pg8::bf_hi(kk.y)
                         + qs[d + 4] * pg8::bf_lo(kk.z) + qs[d + 5] * pg8::bf_hi(kk.z) + qs[d + 6] * pg8::bf_lo(kk.w) + qs[d + 7] * pg8::bf_hi(kk.w); }
                xv = FOX ? dot + (Ft - cum[h * SEQ + s]) * LOG2E : dot - slope2 * (float)(t - s); }
            const float mx = wave_max(xv), mnew = fmaxf(mrun, mx), alpha = exp2f(mrun - mnew);
            const float p = valid ? exp2f(xv - mnew) : 0.f;
            l = l * alpha + wave_sum(p); o0 *= alpha; o1 *= alpha; mrun = mnew;
            ps[lane] = p; LDS_WAIT();
            const int nj = (t - s0 + 1) < 64 ? (t - s0 + 1) : 64;
            for (int j = 0; j < nj; ++j) { const float pj = ps[j]; const bf16* vr = Vb + (size_t)(s0 + j) * D;
                if (FOX) { const unsigned vv = *(const unsigned*)(vr + 2 * lane); o0 += pj * pg8::bf_lo(vv); o1 += pj * pg8::bf_hi(vv); }
                else o0 += pj * bf2f(vr[lane]); }
            LDS_WAIT();
        }
        if (!FOX) l += exp2f(sinks[h] * LOG2E - mrun);
        const float inv = 1.f / l;
        if (FOX) { const unsigned gg = *(const unsigned*)(Gr + 2 * lane);
            *(unsigned*)(O + (size_t)t * 2048 + h * D + 2 * lane) = pk2(o0 * inv * pg8::bf_lo(gg), o1 * inv * pg8::bf_hi(gg)); }
        else O[(size_t)t * 2048 + h * D + lane] = (bf16)f2bf(o0 * inv * bf2f(Gr[lane]));
    }
}

__device__ __forceinline__ void phase_ln_out(const Args& a) {
    const int tid = threadIdx.x, lane = tid & 63, wave = tid >> 6, G = gridDim.x;
    const float* lng = a.in[10]; const float* lnb = a.in[11];
    const int gw = blockIdx.x * NWAVES + wave, NGW = G * NWAVES;
    for (int m = gw; m < SEQ; m += NGW) {
        f32x4* zr = (f32x4*)(a.out + (size_t)m * DM) + lane;
        f32x4 v[8]; float s = 0.f;
#pragma unroll
        for (int j = 0; j < 8; ++j) { v[j] = zr[64 * j]; s += (v[j].x + v[j].y) + (v[j].z + v[j].w); }
        const float mean = wave_sum(s) * (1.f / DM); float s2 = 0.f;
#pragma unroll
        for (int j = 0; j < 8; ++j) { v[j] = v[j] - mean; s2 += (v[j].x * v[j].x + v[j].y * v[j].y) + (v[j].z * v[j].z + v[j].w * v[j].w); }
        const float rstd = 1.f / sqrtf(wave_sum(s2) * (1.f / DM) + LN_EPS);
#pragma unroll
        for (int j = 0; j < 8; ++j) { const f32x4 g = *((const f32x4*)lng + lane + 64 * j), b = *((const f32x4*)lnb + lane + 64 * j); zr[64 * j] = v[j] * rstd * g + b; }
    }
}

#define XB_TMO      128
#define XB_XCNT(j)  (256  + 64 * (j))
#define XB_XSUB(j)  (1280 + 64 * (j))
#define XB_XGEN(j)  (2304 + 64 * (j))
#define XB_TOP      3328
#define XB_TOPGEN   3392
#define XCD_BAR_WORDS 3456
#define XB_SPIN_CAP (1u << 18)

__device__ __forceinline__ unsigned xb_ld(unsigned* p)              { return __hip_atomic_load(p, __ATOMIC_RELAXED, __HIP_MEMORY_SCOPE_AGENT); }
__device__ __forceinline__ unsigned xb_add(unsigned* p, unsigned v) { return __hip_atomic_fetch_add(p, v, __ATOMIC_RELAXED, __HIP_MEMORY_SCOPE_AGENT); }
__device__ __forceinline__ unsigned xb_xcc_id() { return (unsigned)__builtin_amdgcn_s_getreg((3 << 11) | 20) & 0xFu; }
#define XB_SPIN(cond, bar) do { unsigned _sp = 0; while (cond) { __builtin_amdgcn_s_sleep(1); \
    if ((++_sp & 255u) == 0u) { if (xb_ld(&(bar)[XB_TMO])) break; if (_sp > XB_SPIN_CAP) { atomicAdd(&(bar)[XB_TMO], 1u); break; } } } } while (0)

struct XcdBarrier {
    unsigned* bar; unsigned x;
    volatile LAS unsigned* st;
};

__device__ __forceinline__ XcdBarrier xcd_barrier_post(unsigned* bar, volatile LAS unsigned* st) {
    XcdBarrier b; b.bar = bar; b.x = xb_xcc_id(); b.st = st;
    if (threadIdx.x == 0) (void)xb_add(&bar[XB_XCNT(b.x)], 1u);
    return b;
}
__device__ __forceinline__ void xcd_barrier_complete(unsigned* bar, unsigned x, unsigned& nloc, unsigned& nx) {
    const unsigned G = gridDim.x * gridDim.y * gridDim.z;
    unsigned sum, cnt, mine, sp = 0u;
    for (;;) {
        sum = 0u; cnt = 0u; mine = 0u;
#pragma unroll
        for (unsigned j = 0; j < 16; ++j) { const unsigned c = xb_ld(&bar[XB_XCNT(j)]); sum += c; cnt += (c > 0u) ? 1u : 0u; mine = (j == x) ? c : mine; }
        if (sum == G) break;
        __builtin_amdgcn_s_sleep(1);
        if ((++sp & 255u) == 0u) { if (xb_ld(&bar[XB_TMO])) break; if (sp > XB_SPIN_CAP) { atomicAdd(&bar[XB_TMO], 1u); break; } }
    }
    nloc = mine > 0u ? mine : 1u; nx = cnt > 0u ? cnt : 1u;
}

__device__ __forceinline__ void xcd_barrier(const XcdBarrier& b) {
    asm volatile("s_waitcnt vmcnt(0)" ::: "memory");
    __syncthreads();
    if (threadIdx.x == 0) {
        unsigned* bar = b.bar;
        __builtin_amdgcn_s_waitcnt(0);
        unsigned nloc = b.st[0], nx = b.st[1];
        if (nloc == 0u) { xcd_barrier_complete(bar, b.x, nloc, nx); b.st[0] = nloc; b.st[1] = nx; }
        const unsigned old = xb_add(&bar[XB_XSUB(b.x)], 1u);
        const unsigned gen = old / nloc;
        if (old + 1u == (gen + 1u) * nloc) {
            __builtin_amdgcn_fence(__ATOMIC_RELEASE, "agent");
            asm volatile("s_waitcnt vmcnt(0)" ::: "memory");
            const unsigned og = xb_add(&bar[XB_TOP], 1u);
            const unsigned tg = og / nx;
            if (og + 1u == (tg + 1u) * nx) xb_add(&bar[XB_TOPGEN], 1u);
            else XB_SPIN(xb_ld(&bar[XB_TOPGEN]) == tg, bar);
            __builtin_amdgcn_fence(__ATOMIC_ACQUIRE, "agent");
            xb_add(&bar[XB_XGEN(b.x)], 1u);
            asm volatile("s_waitcnt vmcnt(0)" ::: "memory");
        } else {
            XB_SPIN(xb_ld(&bar[XB_XGEN(b.x)]) == gen, bar);
            __builtin_amdgcn_fence(__ATOMIC_ACQUIRE, "agent");
            asm volatile("s_waitcnt vmcnt(0)" ::: "memory");
        }
    }
    __syncthreads();
}


typedef short s16x4 __attribute__((ext_vector_type(4)));
typedef short v4i16_t __attribute__((ext_vector_type(4)));
typedef float f32x2_t __attribute__((ext_vector_type(2)));
typedef __bf16 bf16x2_t __attribute__((ext_vector_type(2)));
#define MFMA32(a, b, c) __builtin_amdgcn_mfma_f32_32x32x16_bf16((a), (b), (c), 0, 0, 0)
__device__ __forceinline__ s16x4 vtr(LAS const unsigned char* p) { return __builtin_bit_cast(s16x4, __builtin_amdgcn_ds_read_tr16_b64_v4i16((LAS v4i16_t*)p)); }
__device__ __forceinline__ unsigned cvtpk(float lo, float hi) { f32x2_t v = {lo, hi}; bf16x2_t b = __builtin_convertvector(v, bf16x2_t); return __builtin_bit_cast(unsigned, b); }
__device__ __forceinline__ float xor32_max(float v) { auto rr = __builtin_amdgcn_permlane32_swap(__float_as_uint(v), __float_as_uint(v), false, false); return fmaxf(__uint_as_float(rr[0]), __uint_as_float(rr[1])); }
__device__ __forceinline__ float xor32_sum(float v) { auto rr = __builtin_amdgcn_permlane32_swap(__float_as_uint(v), __float_as_uint(v), false, false); return __uint_as_float(rr[0]) + __uint_as_float(rr[1]); }
__device__ __forceinline__ int crow(int i, int h) { return (i & 3) + 8 * (i >> 2) + 4 * h; }

template <bool FOX> struct AC {
    static constexpr int D = FOX ? 128 : 64, NDS = D / 16, NDB = D / 32;
    static constexpr int ROWB = D * 2;
    static constexpr int OFF_K = 0, OFF_V = 128 * ROWB, OFF_B = 2 * 128 * ROWB, BUF = OFF_B + 512;
    static constexpr int CPR = D / 8;
    static constexpr int NP = (128 * CPR / 64) / NWAVES;
    static constexpr int W = FOX ? (1 << 30) : 128;
    __device__ static __forceinline__ int swzK(int row) { return FOX ? (row & 15) : ((row >> 1) & 7); }
    __device__ static __forceinline__ int swzV(int row) { return FOX ? (row & 3) : ((row >> 1) & 1); }
};
__device__ __forceinline__ void glds16(const void* gsrc, unsigned lds_dst) { unsigned keep;
    asm volatile("s_mov_b32 %0, m0\n\ts_mov_b32 m0, %2\n\ts_nop 0\n\tglobal_load_lds_dwordx4 %1, off\n\ts_mov_b32 m0, %0" : "=&s"(keep) : "v"(gsrc), "s"(lds_dst) : "memory"); }
#define WAIT_ALL_BAR() asm volatile("s_waitcnt vmcnt(0) lgkmcnt(0)\n\ts_barrier" ::: "memory")
template <bool FOX>
__device__ __forceinline__ void dma_step(const bf16* Pk, const bf16* Pv, int key0, unsigned ldsbuf, int wave, int lane) {
    typedef AC<FOX> C;
#pragma unroll
    for (int i = 0; i < C::NP; ++i) { const int piece = wave * C::NP + i, L = piece * 64 + lane, row = L / C::CPR, cp = L % C::CPR;
        const int kc = cp ^ C::swzK(row), vc = ((((cp >> 2) ^ C::swzV(row)) << 2) | (cp & 3));
        const size_t ro = (size_t)(key0 + row) * C::D;
        glds16(Pk + ro + kc * 8, (unsigned)__builtin_amdgcn_readfirstlane(ldsbuf + C::OFF_K + piece * 1024));
        glds16(Pv + ro + vc * 8, (unsigned)__builtin_amdgcn_readfirstlane(ldsbuf + C::OFF_V + piece * 1024)); }
}

template <bool FOX>
__device__ __forceinline__ bool attn_tileA(LAS const unsigned char* Kb, LAS const float* Bb,
                                           const bf16x8 (&qf)[AC<FOX>::NDS], f32x16 (&oT)[AC<FOX>::NDB], float& m, float& l, bf16x8 (&pf)[2][2],
                                           int ka, int ta, int lane, float slope2) {
    typedef AC<FOX> C;
    const int dmax = ta + 31 - ka, dmin = ta - ka - 63;
    if (dmax < 0 || dmin >= C::W) return false;
    const bool need_mask = (dmin < 0) || (dmax >= C::W);
    const int r = lane & 31, h = lane >> 5;
    f32x16 s0, s1;
    if (FOX) {
#pragma unroll
        for (int g4 = 0; g4 < 4; ++g4) { const f32x4 b0 = *(LAS const f32x4*)(Bb + 8 * g4 + 4 * h), b1 = *(LAS const f32x4*)(Bb + 32 + 8 * g4 + 4 * h);
#pragma unroll
            for (int e = 0; e < 4; ++e) { s0[4 * g4 + e] = b0[e]; s1[4 * g4 + e] = b1[e]; } }
    } else {
#pragma unroll
        for (int i = 0; i < 16; ++i) { s0[i] = 0.f; s1[i] = 0.f; }
    }
    LAS const unsigned char* kp = Kb + r * C::ROWB; const int kx = (h ^ C::swzK(r)) * 16;
#pragma unroll
    for (int ds = 0; ds < C::NDS; ++ds) {
        const bf16x8 k0 = *(LAS const bf16x8*)(kp + (kx ^ (ds * 32))), k1 = *(LAS const bf16x8*)(kp + 32 * C::ROWB + (kx ^ (ds * 32)));
        s0 = MFMA32(k0, qf[ds], s0); s1 = MFMA32(k1, qf[ds], s1);
    }
    const int tl = ta + r - ka;
    if (!FOX) {
#pragma unroll
        for (int i = 0; i < 16; ++i) { const float d0 = (float)(tl - crow(i, h)); s0[i] -= slope2 * d0; s1[i] -= slope2 * (d0 - 32.f); }
    }
    if (need_mask) {
#pragma unroll
        for (int i = 0; i < 16; ++i) { const int d0 = tl - crow(i, h), d1 = d0 - 32;
            if (d0 < 0 || d0 >= C::W) s0[i] = -1e30f;
            if (d1 < 0 || d1 >= C::W) s1[i] = -1e30f; }
    }
    float mx = fmaxf(s0[0], s1[0]);
#pragma unroll
    for (int i = 1; i < 16; ++i) mx = fmaxf(mx, fmaxf(s0[i], s1[i]));
    mx = xor32_max(mx);
    const float mnew = fmaxf(m, mx), alpha = __builtin_amdgcn_exp2f(m - mnew);
    m = mnew;
    float ps = 0.f;
#pragma unroll
    for (int i = 0; i < 16; ++i) { s0[i] = __builtin_amdgcn_exp2f(s0[i] - mnew); s1[i] = __builtin_amdgcn_exp2f(s1[i] - mnew); ps += s0[i] + s1[i]; }
    l = l * alpha + ps;
#pragma unroll
    for (int db = 0; db < C::NDB; ++db) oT[db] = oT[db] * alpha;
#pragma unroll
    for (int s = 0; s < 2; ++s) {
        v4u a, b;
        a.x = cvtpk(s0[8 * s], s0[8 * s + 1]); a.y = cvtpk(s0[8 * s + 2], s0[8 * s + 3]); a.z = cvtpk(s0[8 * s + 4], s0[8 * s + 5]); a.w = cvtpk(s0[8 * s + 6], s0[8 * s + 7]);
        b.x = cvtpk(s1[8 * s], s1[8 * s + 1]); b.y = cvtpk(s1[8 * s + 2], s1[8 * s + 3]); b.z = cvtpk(s1[8 * s + 4], s1[8 * s + 5]); b.w = cvtpk(s1[8 * s + 6], s1[8 * s + 7]);
        pf[0][s] = __builtin_bit_cast(bf16x8, a); pf[1][s] = __builtin_bit_cast(bf16x8, b);
    }
    return true;
}
template <bool FOX>
__device__ __forceinline__ void attn_tileB(LAS const unsigned char* Vb, f32x16 (&oT)[AC<FOX>::NDB], const bf16x8 (&pf)[2][2], int lane) {
    typedef AC<FOX> C;
    const int h = lane >> 5;
    const int i16 = lane & 15, qq = i16 >> 2, pp = i16 & 3, blk = (lane >> 4) & 1;
    const int l0 = (4 * h + qq) * C::ROWB + C::swzV(qq) * 64 + 32 * blk + 8 * pp;
#pragma unroll
    for (int db = 0; db < C::NDB; ++db) {
        LAS const unsigned char* vp = Vb + (l0 ^ (db * 64));
#pragma unroll
        for (int b = 0; b < 2; ++b)
#pragma unroll
            for (int s = 0; s < 2; ++s) {
                const s16x4 lo = vtr(vp + (32 * b + 16 * s) * C::ROWB), hi = vtr(vp + (32 * b + 16 * s + 8) * C::ROWB);
                const bf16x8 va = __builtin_shufflevector(lo, hi, 0, 1, 2, 3, 4, 5, 6, 7);
                oT[db] = MFMA32(va, pf[b][s], oT[db]);
            }
    }
}

__device__ __forceinline__ void fox_unit(const Args& a, LAS unsigned char* lds, int hd, int qb) {
    typedef AC<true> C;
    const int tid = threadIdx.x, lane = tid & 63, wave = __builtin_amdgcn_readfirstlane(tid >> 6), rg = wave & 3, g = wave >> 2;
    const int r = lane & 31, hh = lane >> 5;
    const bf16* P = (const bf16*)(a.ws + WS_PROJ);
    const bf16* Pq = P + pg8::R_FQ + (size_t)hd * SEQ * 128; const bf16* Pk = P + pg8::R_FK + (size_t)hd * SEQ * 128; const bf16* Pv = P + pg8::R_FV + (size_t)hd * SEQ * 128; const bf16* Pg = P + pg8::R_GF + hd * 128;
    const float* cumh = (const float*)(a.ws + WS_CUM) + (size_t)hd * SEQ;
    bf16* O = (bf16*)(a.ws + WS_AF);
    const int q0 = 128 * qb, tq = q0 + 32 * rg + r;
    bf16x8 qf[C::NDS];
#pragma unroll
    for (int ds = 0; ds < C::NDS; ++ds) qf[ds] = *(const bf16x8*)(Pq + (size_t)tq * C::D + ds * 16 + hh * 8);
    const float Fq0 = cumh[q0];
    f32x16 oT[C::NDB];
#pragma unroll
    for (int db = 0; db < C::NDB; ++db)
#pragma unroll
        for (int i = 0; i < 16; ++i) oT[db][i] = 0.f;
    float m = -1e20f, l = 0.f;
    const unsigned lds0 = (unsigned)(uintptr_t)lds;
    float breg = 0.f;
    dma_step<true>(Pk, Pv, 0, lds0, wave, lane);
    if (tid < 128) { breg = cumh[tid]; ((LAS float*)(lds + C::OFF_B))[tid] = (Fq0 - breg) * LOG2E; }
    WAIT_ALL_BAR();
#pragma unroll
    for (int ds = 0; ds < C::NDS; ++ds) asm volatile("" : "+v"(qf[ds]));
    for (int s = 0; s <= qb; ++s) {
        const int cur = (s & 1) * C::BUF, nxt = C::BUF - cur;
        { const int nk = 128 * (s + 1) < SEQ - 128 ? 128 * (s + 1) : SEQ - 128; breg = cumh[nk + (tid & 127)]; }
        if (s < qb) dma_step<true>(Pk, Pv, 128 * (s + 1), lds0 + nxt, wave, lane);
        bf16x8 pf[2][2];
        if (attn_tileA<true>(lds + cur + C::OFF_K + 64 * g * C::ROWB, (LAS const float*)(lds + cur + C::OFF_B) + 64 * g, qf, oT, m, l, pf, 128 * s + 64 * g, q0 + 32 * rg, lane, 0.f))
            attn_tileB<true>(lds + cur + C::OFF_V + 64 * g * C::ROWB, oT, pf, lane);
        const float bval = (Fq0 - breg) * LOG2E; asm volatile("" :: "v"(bval));
        if (s < qb && tid < 128) ((LAS float*)(lds + nxt + C::OFF_B))[tid] = bval;
        WAIT_ALL_BAR();
    }
    LAS float* mg = (LAS float*)lds + rg * (66 * 64) + lane;
    if (g == 1) {
#pragma unroll
        for (int db = 0; db < C::NDB; ++db)
#pragma unroll
            for (int i = 0; i < 16; ++i) mg[(db * 16 + i) * 64] = oT[db][i];
        mg[64 * 64] = m; mg[65 * 64] = l;
    }
    __syncthreads();
    if (g == 0) {
        const float m1 = mg[64 * 64], l1 = mg[65 * 64], mt = fmaxf(m, m1), a0 = __builtin_amdgcn_exp2f(m - mt), a1 = __builtin_amdgcn_exp2f(m1 - mt);
        const float inv = 1.0f / xor32_sum(a0 * l + a1 * l1);
        const float s0 = a0 * inv, s1 = a1 * inv;
#pragma unroll
        for (int db = 0; db < C::NDB; ++db)
#pragma unroll
            for (int g4 = 0; g4 < 4; ++g4) { const int d = 32 * db + 8 * g4 + 4 * hh;
                asm volatile("" ::: "memory");
                const v2u gg = *(const v2u*)(Pg + (size_t)tq * 1024 + d);
                const float o0 = (s0 * oT[db][4 * g4] + s1 * mg[(db * 16 + 4 * g4) * 64]) * pg8::bf_lo(gg.x), o1 = (s0 * oT[db][4 * g4 + 1] + s1 * mg[(db * 16 + 4 * g4 + 1) * 64]) * pg8::bf_hi(gg.x);
                const float o2 = (s0 * oT[db][4 * g4 + 2] + s1 * mg[(db * 16 + 4 * g4 + 2) * 64]) * pg8::bf_lo(gg.y), o3 = (s0 * oT[db][4 * g4 + 3] + s1 * mg[(db * 16 + 4 * g4 + 3) * 64]) * pg8::bf_hi(gg.y);
                v2u w; w.x = cvtpk(o0, o1); w.y = cvtpk(o2, o3);
                *(v2u*)(O + (size_t)tq * 2048 + hd * 128 + d) = w; }
    }
    __syncthreads();
}

__device__ __forceinline__ void swa_unit(const Args& a, LAS unsigned char* lds, int nb, int hp) {
    typedef AC<false> C;
    const int tid = threadIdx.x, lane = tid & 63, wave = __builtin_amdgcn_readfirstlane(tid >> 6), rg = wave & 3, g = wave >> 2;
    const int r = lane & 31, hh = lane >> 5;
    const int head = 2 * hp + g, kvh = hp >> 1;
    const bf16* P = (const bf16*)(a.ws + WS_PROJ);
    const bf16* Pq = P + pg8::R_SQ + (size_t)head * SEQ * 64; const bf16* Pk = P + pg8::R_SK + (size_t)kvh * SEQ * 64; const bf16* Pv = P + pg8::R_SV + (size_t)kvh * SEQ * 64; const bf16* Pg = P + pg8::R_GS + head * 64;
    bf16* O = (bf16*)(a.ws + WS_AF);
    const int q0 = 128 * nb, tq = q0 + 32 * rg + r;
    const float slope2 = exp2f(-8.0f * (float)(head + 1) / 16.0f) * LOG2E;
    bf16x8 qf[C::NDS];
#pragma unroll
    for (int ds = 0; ds < C::NDS; ++ds) qf[ds] = *(const bf16x8*)(Pq + (size_t)tq * C::D + ds * 16 + hh * 8);
    f32x16 oT[C::NDB];
#pragma unroll
    for (int db = 0; db < C::NDB; ++db)
#pragma unroll
        for (int i = 0; i < 16; ++i) oT[db][i] = 0.f;
    float m = -1e20f, l = 0.f;
    const unsigned lds0 = (unsigned)(uintptr_t)lds;
    const int sfirst = nb > 0 ? nb - 1 : 0;
    dma_step<false>(Pk, Pv, 128 * sfirst, lds0, wave, lane);
    WAIT_ALL_BAR();
#pragma unroll
    for (int ds = 0; ds < C::NDS; ++ds) asm volatile("" : "+v"(qf[ds]));
    for (int s = sfirst; s <= nb; ++s) {
        const int cur = ((s - sfirst) & 1) * C::BUF, nxt = C::BUF - cur;
        if (s < nb) dma_step<false>(Pk, Pv, 128 * (s + 1), lds0 + nxt, wave, lane);
#pragma unroll 1
        for (int jt = 0; jt < 2; ++jt)
        { bf16x8 pf[2][2];
            if (attn_tileA<false>(lds + cur + C::OFF_K + 64 * jt * C::ROWB, nullptr, qf, oT, m, l, pf, 128 * s + 64 * jt, q0 + 32 * rg, lane, slope2))
                attn_tileB<false>(lds + cur + C::OFF_V + 64 * jt * C::ROWB, oT, pf, lane); }
        WAIT_ALL_BAR();
    }
    const float inv = 1.0f / (xor32_sum(l) + __builtin_amdgcn_exp2f(a.in[6][head] * LOG2E - m));
#pragma unroll
    for (int db = 0; db < C::NDB; ++db)
#pragma unroll
        for (int g4 = 0; g4 < 4; ++g4) { const int d = 32 * db + 8 * g4 + 4 * hh;
            const v2u gg = *(const v2u*)(Pg + (size_t)tq * 1024 + d);
            const float o0 = oT[db][4 * g4] * inv * pg8::bf_lo(gg.x), o1 = oT[db][4 * g4 + 1] * inv * pg8::bf_hi(gg.x), o2 = oT[db][4 * g4 + 2] * inv * pg8::bf_lo(gg.y), o3 = oT[db][4 * g4 + 3] * inv * pg8::bf_hi(gg.y);
            v2u w; w.x = cvtpk(o0, o1); w.y = cvtpk(o2, o3);
            *(v2u*)(O + (size_t)tq * 2048 + 1024 + head * 64 + d) = w; }
}

#ifndef ATTN_FOX_FAST
#define ATTN_FOX_FAST 1
#endif
#ifndef ATTN_SWA_FAST
#define ATTN_SWA_FAST 1
#endif
__device__ __forceinline__ void phase_attn(const Args& a, LAS unsigned char* lds) {
    const int G = gridDim.x;
#if ATTN_FOX_FAST
    for (int p = blockIdx.x; p < 256; p += G) { const int hd = p & 7, j = p >> 3;
#pragma unroll 1
        for (int k = 0; k < 2; ++k) fox_unit(a, lds, hd, k ? j : 63 - j); }
#else
    naive_attn<true>(a, lds);
#endif
    __syncthreads();
#if ATTN_SWA_FAST
    for (int u = blockIdx.x; u < 512; u += G) { const int hp = u & 7, nb = u >> 3; swa_unit(a, lds, nb, hp); }
#else
    naive_attn<false>(a, lds);
#endif
}

constexpr int N_PHASES = 7;
__global__ void __launch_bounds__(NTHREADS) fwd_megakernel(Args args) {
    extern __shared__ __attribute__((aligned(16))) unsigned char lds_raw[];
    LAS unsigned char* lds = (LAS unsigned char*)lds_raw;
    cg::grid_group grid = cg::this_grid();
    const int lo = args.ph_lo, hi = args.ph_hi;
    const bool one = (lo == 0 && hi == N_PHASES);
    unsigned char* ws = args.ws;
    volatile LAS unsigned* misc = (volatile LAS unsigned*)(lds + LDS_MISC_OFF);
    if (threadIdx.x < 16) misc[threadIdx.x] = 0u;
    __syncthreads();
    XcdBarrier bar; bar.bar = (unsigned*)(ws + WS_BAR); bar.x = 0; bar.st = misc;
    if (one) bar = xcd_barrier_post((unsigned*)(ws + WS_BAR), misc);
#define IN(k) (lo <= (k) && (k) < hi)
#define SEAM_CG() do { if (one) grid.sync(); } while (0)
#define SEAM() do { if (one) xcd_barrier(bar); } while (0)
    SEAM_CG();
    if (IN(0)) { phase0(args, lds); SEAM(); }
    if (IN(1)) { phase1(args, lds); SEAM(); }
    if (IN(2)) {
        if (blockIdx.x < 8) scan_head(args, lds, blockIdx.x);
        pg8::Gemm g{(const pg8::bf16_t*)(ws + WS_H), (const pg8::bf16_t*)(ws + WS_WIN_T), SEQ, LDP, DM};
        pg8::StaticOrder S; S.init(SEQ, LDP, gridDim.x, (int)blockIdx.x);
        pg8::EpiProj E{(pg8::bf16_t*)(ws + WS_PROJ)};
        pg8::gemm_phase<pg8::EpiProj, pg8::StaticOrder, true, true>(lds, g, S, E);
        SEAM();
    }
    if (IN(3)) { phase_attn(args, lds); SEAM(); }
    if (IN(4)) {
        pg8::StaticOrder S; S.init(SEQ, DM, gridDim.x, (int)blockIdx.x);
        pg8::Gemm g{(const pg8::bf16_t*)(ws + WS_AF), (const pg8::bf16_t*)(ws + WS_WBF_T), SEQ, DM, DM};
        pg8::EpiMerge2 E{(const pg8::bf16_t*)(ws + WS_PROJ) + pg8::R_MF, (const pg8::bf16_t*)(ws + WS_PROJ) + pg8::R_MS, (pg8::bf16_t*)(ws + WS_H)};
        pg8::gemm_phase<pg8::EpiMerge2, pg8::StaticOrder, true, true>(lds, g, S, E);
        SEAM();
    }
    if (IN(5)) {
        pg8::StaticOrder S; S.init(SEQ, DM, gridDim.x, (int)blockIdx.x);
        pg8::Gemm g{(const pg8::bf16_t*)(ws + WS_H), (const pg8::bf16_t*)(ws + WS_WOUT_T), SEQ, DM, DM};
        pg8::EpiZ E{args.in[0], (const float*)(ws + WS_ADA) + 2 * DM, args.out, DN_ALPHA};
        pg8::gemm_phase<pg8::EpiZ, pg8::StaticOrder, true, true>(lds, g, S, E);
        SEAM();
    }
    if (IN(6)) { phase_ln_out(args); }
#undef IN
#undef SEAM
#undef SEAM_CG
}

#ifndef MK_N_LAUNCHES
#define MK_N_LAUNCHES 1
#endif
extern "C" void kernel_launch(void* const* d_in, const int* in_sizes, int n_in, void* d_out, int out_size, void* d_ws, size_t ws_size, hipStream_t stream) {
    static int grid = 0;
    if (grid == 0) {
        if (n_in != 12 || out_size != SEQ * DM || ws_size < WS_END) { fprintf(stderr, "kernel_launch: unexpected shapes (n_in %d out %d ws %zu)\n", n_in, out_size, ws_size); grid = -1; return; }
        int dev = 0, cus = 0, per_cu = 0;
        hipGetDevice(&dev);
        hipDeviceGetAttribute(&cus, hipDeviceAttributeMultiprocessorCount, dev);
        if (hipFuncSetAttribute((const void*)fwd_megakernel, hipFuncAttributeMaxDynamicSharedMemorySize, LDS_BYTES) != hipSuccess) { fprintf(stderr, "kernel_launch: hipFuncSetAttribute failed\n"); grid = -1; return; }
        if (hipOccupancyMaxActiveBlocksPerMultiprocessor(&per_cu, (const void*)fwd_megakernel, NTHREADS, LDS_BYTES) != hipSuccess || per_cu < 1) { fprintf(stderr, "kernel_launch: occupancy query says %d\n", per_cu); per_cu = 1; }
        (void)hipGetLastError();
        grid = cus * (per_cu > 1 ? 1 : per_cu);
        fprintf(stderr, "kernel_launch: grid %d (cus %d per_cu %d)\n", grid, cus, per_cu);
    }
    if (grid < 0) return;
    Args a{};
    for (int i = 0; i < 12; ++i) a.in[i] = (const float*)d_in[i];
    a.out = (float*)d_out; a.ws = (unsigned char*)d_ws;
#if MK_N_LAUNCHES == 1
    if (hipMemsetAsync((char*)d_ws + WS_BAR, 0, WS_BAR_BYTES, stream) != hipSuccess) { fprintf(stderr, "kernel_launch: memset failed\n"); return; }
    a.ph_lo = 0; a.ph_hi = N_PHASES;
    void* kargs[] = {&a};
    hipError_t e = hipLaunchCooperativeKernel((const void*)fwd_megakernel, dim3(grid), dim3(NTHREADS), kargs, LDS_BYTES, stream);
    if (e != hipSuccess) fprintf(stderr, "cooperative launch failed: %s (grid %d)\n", hipGetErrorString(e), grid);
#else
#ifndef PROBE_REP
#define PROBE_REP -1
#endif
#ifndef PROBE_VAR
#define PROBE_VAR 0
#endif
    for (int p = 0; p < N_PHASES; ++p) { a.ph_lo = p; a.ph_hi = p + 1;
        for (int rep = 0; rep < (p == PROBE_REP ? 2 : 1); ++rep) { a.var = rep ? PROBE_VAR : 0; hipLaunchKernelGGL(fwd_megakernel, dim3(grid), dim3(NTHREADS), LDS_BYTES, stream, a); } }
#endif
}
```
